# Optimizing an MI355X kernel written in HIP

```python
import jax, jax.numpy as jnp
from jax import lax
import numpy as np

D_MODEL = 1024
BATCH = 8
SEQ = 4096
DEPTH = 2

D_MIX = D_MODEL
GLA_HEADS = 4
GLA_WIDTH = D_MIX // 2
GLA_DV = GLA_WIDTH // GLA_HEADS
GLA_DK = GLA_DV // 2
GLA_LOWRANK = 16
GLA_TAU = 16.0
GLA_CHUNK = 64
DIL_HEADS = 4
DIL_WIDTH = D_MIX - GLA_WIDTH
DIL_HD = DIL_WIDTH // DIL_HEADS
DIL_PATTERNS = ((128, 1), (512, 4), (2048, 16))
ROPE_THETA = 10000.0
EPS = 1e-6
IN_SIZES = (GLA_HEADS * GLA_DK, GLA_HEADS * GLA_DK, GLA_WIDTH, GLA_WIDTH, GLA_LOWRANK,
            DIL_WIDTH, DIL_WIDTH, DIL_WIDTH, DIL_WIDTH)
IN_COLS = sum(IN_SIZES)

kernel_name = "hybrid_gla_dilated_parallel_heads"


def rmsnorm(x, g):
    x32 = x.astype(jnp.float32)
    r = x32 * lax.rsqrt(jnp.mean(x32 * x32, axis=-1, keepdims=True) + EPS)
    return (r * g.astype(jnp.float32)).astype(x.dtype)


def head_rmsnorm(o, g):
    r = o * lax.rsqrt(jnp.mean(o * o, axis=-1, keepdims=True) + EPS)
    B, S, H, dh = o.shape
    return r.reshape(B, S, H * dh) * g.astype(jnp.float32)


def rope(x):
    S, hd = x.shape[1], x.shape[3]
    inv_freq = ROPE_THETA ** (-jnp.arange(0, hd, 2, dtype=jnp.float32) / hd)
    ang = jnp.arange(S, dtype=jnp.float32)[:, None] * inv_freq[None, :]
    cos = jnp.cos(ang)[None, :, None, :]
    sin = jnp.sin(ang)[None, :, None, :]
    x32 = x.astype(jnp.float32)
    x1, x2 = x32[..., : hd // 2], x32[..., hd // 2:]
    return jnp.concatenate([x1 * cos - x2 * sin, x2 * cos + x1 * sin], axis=-1)


def gla_mixer(q, k, v, lr, w_gate_up, b_gate_up):
    B, S, H, DK = q.shape
    DV = v.shape[-1]
    C = GLA_CHUNK
    n = S // C
    z = jnp.einsum('bsr,rk->bsk', lr.astype(jnp.float32), w_gate_up.astype(jnp.float32)) + b_gate_up.astype(jnp.float32)
    log_a = jax.nn.log_sigmoid(z).reshape(B, S, H, DK) / GLA_TAU

    def chunks(t):
        return t.astype(jnp.float32).reshape(B, n, C, H, t.shape[-1]).transpose(0, 3, 1, 2, 4)

    qc, kc, vc, la = chunks(q), chunks(k), chunks(v), chunks(log_a)
    b = jnp.cumsum(la, axis=3)
    q_e = qc * jnp.exp(b)
    k_e = kc * jnp.exp(-b)
    causal = jnp.tril(jnp.ones((C, C), dtype=bool))
    A = jnp.where(causal, jnp.einsum('bhnik,bhnjk->bhnij', q_e, k_e), 0.0)
    o_intra = jnp.einsum('bhnij,bhnjv->bhniv', A, vc)
    b_last = b[:, :, :, -1, :]
    k_end = kc * jnp.exp(b_last[:, :, :, None, :] - b)
    chunk_state = jnp.einsum('bhnjk,bhnjv->bhnkv', k_end, vc)
    decay = jnp.exp(b_last)

    def step(state, inp):
        dec, cs = inp
        return dec[..., None] * state + cs, state

    init = jnp.zeros((B, H, DK, DV), jnp.float32)
    _, before = lax.scan(step, init, (jnp.moveaxis(decay, 2, 0), jnp.moveaxis(chunk_state, 2, 0)))
    before = jnp.moveaxis(before, 0, 2)
    o = o_intra + jnp.einsum('bhnik,bhnkv->bhniv', q_e, before)
    return o.transpose(0, 2, 3, 1, 4).reshape(B, S, H, DV)


def dilated_pattern(q, k, v, window, dilation):
    B, S, H, hd = q.shape
    lb = window // dilation
    span = lb * dilation
    s_pad = -(-S // span) * span
    pad = s_pad - S
    L = s_pad // dilation
    nb = L // lb

    def to_blocks(t):
        t = jnp.pad(t, ((0, 0), (0, pad), (0, 0), (0, 0)))
        t = t.reshape(B, L, dilation, H, hd).transpose(0, 3, 2, 1, 4)
        return t.reshape(B, H, dilation, nb, lb, hd)

    def with_prev(t):
        prev = jnp.concatenate([jnp.zeros_like(t[:, :, :, :1]), t[:, :, :, :-1]], axis=3)
        return jnp.concatenate([prev, t], axis=4)

    qb = to_blocks(q)
    kk = with_prev(to_blocks(k))
    vv = with_prev(to_blocks(v))
    s = jnp.einsum('bhrnqd,bhrnkd->bhrnqk', qb, kk) * (hd ** -0.5)
    qi = jnp.arange(lb)[:, None]
    ki = jnp.arange(2 * lb)[None, :]
    dist = qi + lb - ki
    blk = jnp.arange(nb)[:, None, None]
    valid = (dist >= 0) & (dist <= lb) & ((blk > 0) | (ki >= lb)[None])
    s = jnp.where(valid, s, -jnp.inf)
    m = jnp.max(s, axis=-1, keepdims=True)
    p = jnp.exp(s - m)
    den = jnp.sum(p, axis=-1)
    o = jnp.einsum('bhrnqk,bhrnkd->bhrnqd', p, vv) / den[..., None]
    lse = m[..., 0] + jnp.log(den)
    o = o.reshape(B, H, dilation, L, hd).transpose(0, 3, 2, 1, 4).reshape(B, s_pad, H, hd)[:, :S]
    lse = lse.reshape(B, H, dilation, L).transpose(0, 3, 2, 1).reshape(B, s_pad, H)[:, :S]
    return o, lse


def dilated_mixer(q, k, v):
    v = v.astype(jnp.float32)
    outs, lses = [], []
    for window, dilation in DIL_PATTERNS:
        o, lse = dilated_pattern(q, k, v, window, dilation)
        outs.append(o)
        lses.append(lse)
    w = jax.nn.softmax(jnp.stack(lses, axis=0), axis=0)
    return jnp.sum(w[..., None] * jnp.stack(outs, axis=0), axis=0)


def hybrid_layer(x, c, w_ada, b_ada, g_pre, w_in, w_gate_up, b_gate_up, g_gla, g_dil, w_out, g_post):
    B, S, D = x.shape
    mod = jnp.einsum('bd,de->be', jax.nn.silu(c), w_ada) + b_ada
    shift, scale, gate = jnp.split(mod, 3, axis=-1)
    h = rmsnorm(x, g_pre) * (1 + scale[:, None, :]) + shift[:, None, :]
    proj = jnp.einsum('bsd,de->bse', h, w_in)
    offs = [int(o) for o in np.cumsum(IN_SIZES)[:-1]]
    q_a, k_a, v_a, z_a, lr, q_b, k_b, v_b, z_b = jnp.split(proj, offs, axis=-1)
    q_a = q_a.reshape(B, S, GLA_HEADS, GLA_DK) * (GLA_DK ** -0.5)
    k_a = k_a.reshape(B, S, GLA_HEADS, GLA_DK)
    v_a = v_a.reshape(B, S, GLA_HEADS, GLA_DV)
    o_a = gla_mixer(q_a, k_a, v_a, lr, w_gate_up, b_gate_up)
    y_a = head_rmsnorm(o_a, g_gla) * jax.nn.silu(z_a.astype(jnp.float32))
    q_b = rope(q_b.reshape(B, S, DIL_HEADS, DIL_HD))
    k_b = rope(k_b.reshape(B, S, DIL_HEADS, DIL_HD))
    v_b = v_b.reshape(B, S, DIL_HEADS, DIL_HD)
    o_b = dilated_mixer(q_b, k_b, v_b)
    y_b = head_rmsnorm(o_b, g_dil) * jax.nn.silu(z_b.astype(jnp.float32))
    y = jnp.concatenate([y_a, y_b], axis=-1).astype(x.dtype)
    y = jnp.einsum('bse,ed->bsd', y, w_out)
    return x + gate[:, None, :] * rmsnorm(y, g_post)


def setup_inputs(seed: int = 0) -> dict:
    key = jax.random.key(seed)
    ks = jax.random.split(key, 14)
    f = jnp.float32
    nrm = lambda k, shape, s: jax.random.normal(k, shape, f) * s
    return {
        "x": nrm(ks[0], (BATCH, SEQ, D_MODEL), 1.0),
        "c": nrm(ks[1], (BATCH, D_MODEL), 1.0),
        "w_ada": nrm(ks[2], (DEPTH, D_MODEL, 3 * D_MODEL), D_MODEL ** -0.5),
        "b_ada": nrm(ks[3], (DEPTH, 3 * D_MODEL), 0.02),
        "g_pre": 1.0 + nrm(ks[4], (DEPTH, D_MODEL), 0.02),
        "w_in": nrm(ks[5], (DEPTH, D_MODEL, IN_COLS), D_MODEL ** -0.5),
        "w_gate_up": nrm(ks[6], (DEPTH, GLA_LOWRANK, GLA_HEADS * GLA_DK), GLA_LOWRANK ** -0.5),
        "b_gate_up": nrm(ks[7], (DEPTH, GLA_HEADS * GLA_DK), 0.1),
        "g_gla": 1.0 + nrm(ks[8], (DEPTH, GLA_WIDTH), 0.02),
        "g_dil": 1.0 + nrm(ks[9], (DEPTH, DIL_WIDTH), 0.02),
        "w_out": nrm(ks[10], (DEPTH, D_MIX, D_MODEL), D_MIX ** -0.5),
        "g_post": 1.0 + nrm(ks[11], (DEPTH, D_MODEL), 0.02),
    }


def reference(x, c, w_ada, b_ada, g_pre, w_in, w_gate_up, b_gate_up, g_gla, g_dil, w_out, g_post):
    for l in range(DEPTH):
        x = hybrid_layer(x, c, w_ada[l], b_ada[l], g_pre[l], w_in[l], w_gate_up[l], b_gate_up[l],
                         g_gla[l], g_dil[l], w_out[l], g_post[l])
    return x
```

```cpp
#include <hip/hip_runtime.h>
#include <cstdio>
#include <cstdint>
namespace pg8 {
#define PG8_LAS __attribute__((address_space(3)))
typedef unsigned short bf16_t;
typedef short bf16x8 __attribute__((ext_vector_type(8)));
typedef float f32x4 __attribute__((ext_vector_type(4)));
typedef unsigned u32x4 __attribute__((ext_vector_type(4)));
constexpr int BM = 256, BK = 64, HALF = 128, HTB = HALF * BK * 2  , STAGE_BYTES = 8 * HTB, NXCD = 8, WGM = 8;

__host__ __device__ __forceinline__ int lds_byte(int r, int c) { const int st = (r >> 4) * 2 + (c >> 5), rr = r & 15, cc = c & 31, ob = rr * 64 + cc * 2; return st * 1024 + (ob ^ (((ob >> 9) & 1) << 5)); }
__host__ __device__ __forceinline__ void stage_rc(int b, int& R, int& C) { const int st = b / 1024, sb = b % 1024, swz = sb ^ (((sb >> 9) & 1) << 5); R = (st >> 1) * 16 + swz / 64; C = (st & 1) * 32 + (swz % 64) / 2; }
__host__ __device__ __forceinline__ int perm32(int rho) { const int n = rho >> 4, i = rho & 15; return 8 * (i >> 2) + 4 * n + (i & 3); }

struct Unit { int pm, pn; };
struct Gemm { const bf16_t* A; const bf16_t* Bt; int M, N, K; };

struct StaticOrder {
    int nM, nN, nwg, G, c;
    __host__ __device__ void init(int M, int N, int G_, int c_) { nM = M / BM; nN = N / BM; nwg = nM * nN; G = G_; c = c_; }
    __host__ __device__ bool next(int i, Unit& u) const {
        const long L = (long)i * G + c; if (L >= nwg) return false;
        int wgid = (int)L; { const int q = nwg / NXCD, r = nwg % NXCD, xcd = wgid % NXCD, off = wgid / NXCD; wgid = (xcd < r ? xcd * (q + 1) : r * (q + 1) + (xcd - r) * q) + off; }
        const int nig = WGM * nN, gid = wgid / nig, fm = gid * WGM, gsz = (nM - fm) < WGM ? (nM - fm) : WGM;
        u.pm = fm + ((wgid % nig) % gsz); u.pn = (wgid % nig) / gsz; return true;
    }
    __device__ __forceinline__ void a_ready(const Unit&) const {}
    __device__ __forceinline__ void done(const Unit&) const {}
};
__device__ __forceinline__ unsigned cvt_pk_bf16(float lo, float hi) { unsigned r; asm volatile("v_cvt_pk_bf16_f32 %0, %1, %2" : "=v"(r) : "v"(lo), "v"(hi)); return r; }
template <class Epi, class Sched, bool STAMP = false>
__device__ __forceinline__ void gemm_phase(PG8_LAS unsigned char* lds, const Gemm g, const Sched& S, const Epi& E, unsigned long long* stamps) {
    int tid_ = threadIdx.x; asm volatile("" : "+v"(tid_)); const int tid = tid_, wid = __builtin_amdgcn_readfirstlane(tid >> 6), lane = tid & 63, wr = wid >> 2, wc = wid & 3, fr = lane & 15, fq = lane >> 4;
    const int K = g.K, nt = K / BK;
    int ts_lo = 0, ts_hi = 0, nts = 0; const unsigned long long rt_entry = STAMP ? (unsigned long long)wall_clock64() : 0ull;
#define PG8_STAMP() do { if (STAMP && wid == 0 && nts < 64) { const unsigned long long _c = (unsigned long long)clock64(); \
        ts_lo = (lane == nts) ? (int)(unsigned)_c : ts_lo; ts_hi = (lane == nts) ? (int)(unsigned)(_c >> 32) : ts_hi; ++nts; } } while (0)
    PG8_STAMP();
    unsigned voffA[2], voffB[2];
#pragma unroll
    for (int i = 0; i < 2; ++i) { int R, C; stage_rc(tid * 16 + i * 8192, R, C); const int Rb = Epi::PERM ? ((R & ~31) + perm32(R & 31)) : R;
        voffA[i] = (unsigned)(R * K + C) * 2u; voffB[i] = (unsigned)(Rb * K + C) * 2u; }
    const size_t kstep = (size_t)(BK * 2);
    const size_t hstep = (size_t)HALF * K * 2;
    const size_t tstep = 2 * hstep;
    const unsigned ldsw = (unsigned)wid * 1024u;
    const int aoff = lds_byte(wr * 64 + fr, fq * 8), boff = lds_byte(wc * 32 + fr, fq * 8);
#define PG8_SA(b, h) (((b) * 2 + (h)) * HTB)
#define PG8_SB(b, h) ((4 + (b) * 2 + (h)) * HTB)
#define PG8_STAGE(bufoff, gbase, voff) do { _Pragma("unroll") for (int _i = 0; _i < 2; ++_i) \
        __builtin_amdgcn_global_load_lds((const unsigned*)((const char*)(gbase) + (voff)[_i]), (PG8_LAS unsigned*)(lds + (bufoff) + ldsw + _i * 8192), 16, 0, 0); } while (0)
#define PG8_LDA(dst, b, h) do { _Pragma("unroll") for (int m = 0; m < 4; ++m) _Pragma("unroll") for (int k = 0; k < 2; ++k) dst[m][k] = *(const PG8_LAS bf16x8*)(lds + PG8_SA(b, h) + aoff + m * 2048 + k * 1024); } while (0)
#define PG8_LDB(dst, b, h) do { _Pragma("unroll") for (int n = 0; n < 2; ++n) _Pragma("unroll") for (int k = 0; k < 2; ++k) dst[n][k] = *(const PG8_LAS bf16x8*)(lds + PG8_SB(b, h) + boff + n * 2048 + k * 1024); } while (0)
#define PG8_MMA(ai, bj, At, Bt) do { __builtin_amdgcn_s_setprio(1); _Pragma("unroll") for (int m = 0; m < 4; ++m) _Pragma("unroll") for (int n = 0; n < 2; ++n) _Pragma("unroll") for (int k = 0; k < 2; ++k) \
        acc[ai][bj][m][n] = __builtin_amdgcn_mfma_f32_16x16x32_bf16(Bt[n][k], At[m][k], acc[ai][bj][m][n], 0, 0, 0); __builtin_amdgcn_s_setprio(0); } while (0)
#define PG8_WAIT_V(n) asm volatile("s_waitcnt vmcnt(" #n ")" ::: "memory")
#define PG8_WAIT_L(n) asm volatile("s_waitcnt lgkmcnt(" #n ")" ::: "memory")
#define PG8_BAR __builtin_amdgcn_s_barrier()
#define PG8_SCHED __builtin_amdgcn_sched_barrier(0)
    Unit cur, nxt; int ui = 0;
    if (!S.next(0, cur)) return;
    f32x4 acc[2][2][4][2];
#pragma unroll
    for (int a = 0; a < 2; ++a)
#pragma unroll
        for (int b = 0; b < 2; ++b)
#pragma unroll
            for (int m = 0; m < 4; ++m)
#pragma unroll
                for (int n = 0; n < 2; ++n) acc[a][b][m][n] = (f32x4){0.f, 0.f, 0.f, 0.f};
    bf16x8 At[4][2], B0[2][2], B1[2][2];
    const char* cA = (const char*)g.A + (size_t)cur.pm * tstep; const char* cB = (const char*)g.Bt + (size_t)cur.pn * tstep;
    S.a_ready(cur);
    PG8_STAGE(PG8_SB(0, 0), cB, voffB); PG8_STAGE(PG8_SA(0, 0), cA, voffA); PG8_STAGE(PG8_SB(0, 1), cB + hstep, voffB); PG8_STAGE(PG8_SA(0, 1), cA + hstep, voffA);
    if (wr == 1) PG8_BAR;
    PG8_WAIT_V(4); PG8_BAR;
    PG8_STAGE(PG8_SB(1, 0), cB + kstep, voffB); PG8_STAGE(PG8_SA(1, 0), cA + kstep, voffA); PG8_STAGE(PG8_SB(1, 1), cB + hstep + kstep, voffB);
    PG8_WAIT_V(6); PG8_BAR;
    PG8_STAMP();
    for (;;) {
        const bool has_next = S.next(ui + 1, nxt);
        const char* nA = has_next ? (const char*)g.A + (size_t)nxt.pm * tstep : cA; const char* nB = has_next ? (const char*)g.Bt + (size_t)nxt.pn * tstep : cB;
        for (int t = 0; t < nt; t += 2) {
            const bool last = (t == nt - 2);
            const char* a1 = cA + (size_t)(t + 1) * kstep;
            const char* a2 = last ? nA : cA + (size_t)(t + 2) * kstep; const char* b2 = last ? nB : cB + (size_t)(t + 2) * kstep;
            const char* a3 = a2 + kstep; const char* b3 = b2 + kstep;
            if (last && has_next) S.a_ready(nxt);
            PG8_LDB(B0, 0, 0); PG8_SCHED; PG8_LDA(At, 0, 0); PG8_STAGE(PG8_SA(1, 1), a1 + hstep, voffA);
            PG8_WAIT_L(8); PG8_BAR; PG8_WAIT_L(0); PG8_MMA(0, 0, At, B0); PG8_BAR; PG8_SCHED;
            PG8_LDB(B1, 0, 1); PG8_STAGE(PG8_SB(0, 0), b2, voffB);
            PG8_BAR; PG8_WAIT_L(0); PG8_MMA(0, 1, At, B1); PG8_BAR;
            PG8_LDA(At, 0, 1); PG8_STAGE(PG8_SA(0, 0), a2, voffA);
            PG8_BAR; PG8_WAIT_L(0); PG8_MMA(1, 0, At, B0); PG8_BAR; PG8_SCHED;
            PG8_STAGE(PG8_SB(0, 1), b2 + hstep, voffB);
            PG8_WAIT_V(6); PG8_BAR; PG8_MMA(1, 1, At, B1); PG8_BAR;
            PG8_LDB(B0, 1, 0); PG8_SCHED; PG8_LDA(At, 1, 0); PG8_STAGE(PG8_SA(0, 1), a2 + hstep, voffA);
            PG8_WAIT_L(8); PG8_BAR; PG8_WAIT_L(0); PG8_MMA(0, 0, At, B0); PG8_BAR; PG8_SCHED;
            PG8_LDB(B1, 1, 1); PG8_STAGE(PG8_SB(1, 0), b3, voffB);
            PG8_BAR; PG8_WAIT_L(0); PG8_MMA(0, 1, At, B1); PG8_BAR;
            PG8_LDA(At, 1, 1); PG8_STAGE(PG8_SA(1, 0), a3, voffA);
            PG8_BAR; PG8_WAIT_L(0); PG8_MMA(1, 0, At, B0); PG8_BAR; PG8_SCHED;
            PG8_STAGE(PG8_SB(1, 1), b3 + hstep, voffB);
            PG8_WAIT_V(6); PG8_BAR; PG8_MMA(1, 1, At, B1); PG8_BAR;
        }
        PG8_STAMP();
        if constexpr (!Epi::AFTER_DRAIN) { E(acc, cur, wr, wc, fr, fq); S.done(cur); }
        PG8_STAMP();
        if (!has_next) break;
#pragma unroll
        for (int a = 0; a < 2; ++a)
#pragma unroll
            for (int b = 0; b < 2; ++b)
#pragma unroll
                for (int m = 0; m < 4; ++m)
#pragma unroll
                    for (int n = 0; n < 2; ++n) acc[a][b][m][n] = (f32x4){0.f, 0.f, 0.f, 0.f};
        cur = nxt; cA = nA; cB = nB; ++ui;
    }
    PG8_WAIT_V(0);
    if (wr == 0) PG8_BAR;
    PG8_BAR;
    if constexpr (Epi::AFTER_DRAIN) { E.fused(acc, cur, wr, wc, fr, fq, lds, wid, lane); S.done(cur); }
    PG8_STAMP();
    if (STAMP && wid == 0) { stamps[lane] = lane < nts ? (((unsigned long long)(unsigned)ts_hi << 32) | (unsigned)ts_lo) : 0ull;
        if (lane == 62) stamps[62] = rt_entry; if (lane == 63) stamps[63] = (unsigned long long)wall_clock64(); }
#undef PG8_STAMP
#undef PG8_SA
#undef PG8_SB
#undef PG8_STAGE
#undef PG8_LDA
#undef PG8_LDB
#undef PG8_MMA
#undef PG8_WAIT_V
#undef PG8_WAIT_L
#undef PG8_BAR
#undef PG8_SCHED
}
}
#define XB_TMO      128
#define XB_XCNT(j)  (256  + 64 * (j))
#define XB_XSUB(j)  (1280 + 64 * (j))
#define XB_XGEN(j)  (2304 + 64 * (j))
#define XB_TOP      3328
#define XB_TOPGEN   3392
#define XCD_BAR_WORDS 3456
#define XB_SPIN_CAP (1u << 18)
#define LAS __attribute__((address_space(3)))

__device__ __forceinline__ unsigned xb_ld(unsigned* p)              { return __hip_atomic_load(p, __ATOMIC_RELAXED, __HIP_MEMORY_SCOPE_AGENT); }
__device__ __forceinline__ unsigned xb_add(unsigned* p, unsigned v) { return __hip_atomic_fetch_add(p, v, __ATOMIC_RELAXED, __HIP_MEMORY_SCOPE_AGENT); }
__device__ __forceinline__ unsigned xb_xcc_id() { return (unsigned)__builtin_amdgcn_s_getreg((3 << 11) | 20) & 0xFu; }
#define XB_SPIN(cond, bar) do { unsigned _sp = 0; while (cond) { __builtin_amdgcn_s_sleep(1); \
    if ((++_sp & 255u) == 0u) { if (xb_ld(&(bar)[XB_TMO])) break; if (_sp > XB_SPIN_CAP) { atomicAdd(&(bar)[XB_TMO], 1u); break; } } } } while (0)

struct XcdBarrier {
    unsigned* bar; unsigned x;
    volatile LAS unsigned* st;
};

__device__ __forceinline__ XcdBarrier xcd_barrier_post(unsigned* bar, volatile LAS unsigned* st) {
    XcdBarrier b; b.bar = bar; b.x = xb_xcc_id(); b.st = st;
    if (threadIdx.x == 0) (void)xb_add(&bar[XB_XCNT(b.x)], 1u);
    return b;
}
__device__ __forceinline__ void xcd_barrier_complete(unsigned* bar, unsigned x, unsigned& nloc, unsigned& nx) {
    const unsigned G = gridDim.x * gridDim.y * gridDim.z;
    unsigned sum, cnt, mine, sp = 0u;
    for (;;) {
        sum = 0u; cnt = 0u; mine = 0u;
#pragma unroll
        for (unsigned j = 0; j < 16; ++j) { const unsigned c = xb_ld(&bar[XB_XCNT(j)]); sum += c; cnt += (c > 0u) ? 1u : 0u; mine = (j == x) ? c : mine; }
        if (sum == G) break;
        __builtin_amdgcn_s_sleep(1);
        if ((++sp & 255u) == 0u) { if (xb_ld(&bar[XB_TMO])) break; if (sp > XB_SPIN_CAP) { atomicAdd(&bar[XB_TMO], 1u); break; } }
    }
    nloc = mine > 0u ? mine : 1u; nx = cnt > 0u ? cnt : 1u;
}

__device__ __forceinline__ void xcd_barrier(const XcdBarrier& b) {
    asm volatile("s_waitcnt vmcnt(0)" ::: "memory");
    __syncthreads();
    if (threadIdx.x == 0) {
        unsigned* bar = b.bar;
        __builtin_amdgcn_s_waitcnt(0);
        unsigned nloc = b.st[0], nx = b.st[1];
        if (nloc == 0u) { xcd_barrier_complete(bar, b.x, nloc, nx); b.st[0] = nloc; b.st[1] = nx; }
        const unsigned old = xb_add(&bar[XB_XSUB(b.x)], 1u);
        const unsigned gen = old / nloc;
        if (old + 1u == (gen + 1u) * nloc) {
            __builtin_amdgcn_fence(__ATOMIC_RELEASE, "agent");
            asm volatile("s_waitcnt vmcnt(0)" ::: "memory");
            const unsigned og = xb_add(&bar[XB_TOP], 1u);
            const unsigned tg = og / nx;
            if (og + 1u == (tg + 1u) * nx) xb_add(&bar[XB_TOPGEN], 1u);
            else XB_SPIN(xb_ld(&bar[XB_TOPGEN]) == tg, bar);
            __builtin_amdgcn_fence(__ATOMIC_ACQUIRE, "agent");
            xb_add(&bar[XB_XGEN(b.x)], 1u);
            asm volatile("s_waitcnt vmcnt(0)" ::: "memory");
        } else {
            XB_SPIN(xb_ld(&bar[XB_XGEN(b.x)]) == gen, bar);
            __builtin_amdgcn_fence(__ATOMIC_ACQUIRE, "agent");
            asm volatile("s_waitcnt vmcnt(0)" ::: "memory");
        }
    }
    __syncthreads();
}
namespace mk {
using pg8::bf16_t; using pg8::bf16x8; using pg8::f32x4;
typedef short s16x4 __attribute__((ext_vector_type(4)));
typedef unsigned u32x4 __attribute__((ext_vector_type(4)));
typedef unsigned u32x2 __attribute__((ext_vector_type(2)));
#define LDSP __attribute__((address_space(3)))
#define DI __device__ __forceinline__
DI int otid() { int t = threadIdx.x; asm volatile("" : "+v"(t)); return t; }
DI int obid() { int t = blockIdx.x; asm volatile("" : "+s"(t)); return t; }

constexpr int NB = 8, SEQ = 4096, DM = 1024, NTOK = NB * SEQ, NP = 3840, NIN = 3600;
constexpr int C_QA = 0, C_KA = 256, C_VA = 512, C_ZA = 1024, C_LA = 1536, C_QB = 1792, C_KB = 2304, C_VB = 2816, C_ZB = 3328;
constexpr float EPS = 1e-6f;
constexpr int ATT_RS = 272;
constexpr int LDS_BAR_OFF = 2 * 256 * ATT_RS;
constexpr int LDS_BYTES = LDS_BAR_OFF + 64;

struct Params {
    const float *x, *c, *w_ada, *b_ada, *g_pre, *w_in, *w_gu, *b_gu, *g_gla, *g_dil, *w_out, *g_post;
    float* out;
    unsigned* bar; float* mod; float2* rope; bf16_t* winT; bf16_t* woutT; bf16_t* hy; bf16_t* proj; float* yout;
    bf16_t* attO; float* attL; float* gst; float* gdec;
};

DI float bf2f(unsigned short b) { return __uint_as_float(((unsigned)b) << 16); }
DI unsigned short f2bf(float f) { unsigned u = __float_as_uint(f); u += 0x7FFFu + ((u >> 16) & 1u); return (unsigned short)(u >> 16); }
DI unsigned pk2(float lo, float hi) { return (unsigned)f2bf(lo) | ((unsigned)f2bf(hi) << 16); }
DI float silu(float v) { return v / (1.0f + __expf(-v)); }
DI f32x4 mfma16(bf16x8 a, bf16x8 b, f32x4 c) { return __builtin_amdgcn_mfma_f32_16x16x32_bf16(a, b, c, 0, 0, 0); }
DI s16x4 tr4(LDSP unsigned char* base, int row, int rs, int colbyte) {
    return __builtin_amdgcn_ds_read_tr16_b64_v4i16((LDSP s16x4*)(base + row * rs + colbyte));
}
DI bf16x8 cat8(s16x4 a, s16x4 b) { return __builtin_shufflevector(a, b, 0, 1, 2, 3, 4, 5, 6, 7); }
DI bf16x8 pack8(f32x4 a, f32x4 b) {
    typedef unsigned u32x4 __attribute__((ext_vector_type(4)));
    u32x4 r; r[0] = pk2(a[0], a[1]); r[1] = pk2(a[2], a[3]); r[2] = pk2(b[0], b[1]); r[3] = pk2(b[2], b[3]);
    return __builtin_bit_cast(bf16x8, r);
}

struct EpiProj {
    static constexpr bool PERM = true, AFTER_DRAIN = false;
    bf16_t* O; const float* bgu; const float2* rope;
    DI void store8(bf16_t* p, f32x4 v0, f32x4 v1) const {
        uint4 o; o.x = pk2(v0[0], v0[1]); o.y = pk2(v0[2], v0[3]); o.z = pk2(v1[0], v1[1]); o.w = pk2(v1[2], v1[3]);
        *(uint4*)p = o;
    }
    DI void operator()(const f32x4 (&acc)[2][2][4][2], const pg8::Unit& u, int wr, int wc, int fr, int fq) const {
        const int row0 = u.pm * 256 + wr * 64 + fr, col0 = u.pn * 256 + wc * 32 + 8 * fq;
        if (u.pn == 6) {
            f32x4 bv[2][2];
#pragma unroll
            for (int bj = 0; bj < 2; ++bj)
#pragma unroll
                for (int n = 0; n < 2; ++n) bv[bj][n] = *(const f32x4*)(bgu + (col0 - C_LA) + bj * 128 + 4 * n);
#pragma unroll
            for (int ai = 0; ai < 2; ++ai)
#pragma unroll
                for (int m = 0; m < 4; ++m) {
                    bf16_t* rowp = O + (size_t)(row0 + ai * 128 + m * 16) * NP + col0;
#pragma unroll
                    for (int bj = 0; bj < 2; ++bj) {
                        f32x4 v[2];
#pragma unroll
                        for (int n = 0; n < 2; ++n)
#pragma unroll
                            for (int e = 0; e < 4; ++e) { const float z = acc[ai][bj][m][n][e] + bv[bj][n][e];
                                v[n][e] = (fminf(z, 0.f) - __logf(1.0f + __expf(-fabsf(z)))) * 0.0625f; }
                        store8(rowp + bj * 128, v[0], v[1]);
                    }
                }
        } else if (u.pn >= 7 && u.pn <= 10) {
            const int j0 = 16 * wc + 4 * fq;
#pragma unroll
            for (int ai = 0; ai < 2; ++ai)
#pragma unroll
                for (int m = 0; m < 4; ++m) {
                    const int row = row0 + ai * 128 + m * 16, pos = row & (SEQ - 1);
                    const f32x4 t0 = *(const f32x4*)(rope + pos * 64 + j0), t1 = *(const f32x4*)(rope + pos * 64 + j0 + 2);
                    bf16_t* rowp = O + (size_t)row * NP + col0;
#pragma unroll
                    for (int bj = 0; bj < 2; ++bj) {
                        const f32x4 a0 = acc[ai][bj][m][0], a1 = acc[ai][bj][m][1]; f32x4 v0, v1;
                        v0[0] = a0[0] * t0[0] - a0[1] * t0[1]; v0[1] = a0[1] * t0[0] + a0[0] * t0[1];
                        v0[2] = a0[2] * t0[2] - a0[3] * t0[3]; v0[3] = a0[3] * t0[2] + a0[2] * t0[3];
                        v1[0] = a1[0] * t1[0] - a1[1] * t1[1]; v1[1] = a1[1] * t1[0] + a1[0] * t1[1];
                        v1[2] = a1[2] * t1[2] - a1[3] * t1[3]; v1[3] = a1[3] * t1[2] + a1[2] * t1[3];
                        store8(rowp + bj * 128, v0, v1);
                    }
                }
        } else {
#pragma unroll
            for (int ai = 0; ai < 2; ++ai)
#pragma unroll
                for (int m = 0; m < 4; ++m) {
                    bf16_t* rowp = O + (size_t)(row0 + ai * 128 + m * 16) * NP + col0;
#pragma unroll
                    for (int bj = 0; bj < 2; ++bj) store8(rowp + bj * 128, acc[ai][bj][m][0], acc[ai][bj][m][1]);
                }
        }
    }
};
struct EpiOut {
    static constexpr bool PERM = false, AFTER_DRAIN = false;
    float* C;
    DI void operator()(const f32x4 (&acc)[2][2][4][2], const pg8::Unit& u, int wr, int wc, int fr, int fq) const {
        const int row0 = u.pm * 256 + wr * 64 + fr, col0 = u.pn * 256 + wc * 32 + 4 * fq;
#pragma unroll
        for (int ai = 0; ai < 2; ++ai)
#pragma unroll
            for (int m = 0; m < 4; ++m) { float* rowp = C + (size_t)(row0 + ai * 128 + m * 16) * DM + col0;
#pragma unroll
                for (int bj = 0; bj < 2; ++bj)
#pragma unroll
                    for (int n = 0; n < 2; ++n) *(f32x4*)(rowp + bj * 128 + n * 16) = acc[ai][bj][m][n]; }
    }
};

DI void rope_entry(int pos, int j, float& co, float& si) {
    const double invd = exp2(-(double)(2 * j) * (13.287712379549449 / 128.0));
    const float invf = (float)invd, angf = (float)pos * invf;
    const double a = (double)angf, k = rint(a * 0.6366197723675814);
    double y = fma(-k, 1.5707963267948966, a); y = fma(-k, 6.123233995736766e-17, y);
    const int q = ((int)k) & 3; const double y2 = y * y;
    double sp = -2.5052108385441720e-08; sp = sp * y2 + 2.7557319223985893e-06; sp = sp * y2 - 1.9841269841269841e-04; sp = sp * y2 + 8.3333333333333332e-03; sp = sp * y2 - 1.6666666666666666e-01; sp = y + y * y2 * sp;
    double cp = 2.0876756987868100e-09; cp = cp * y2 - 2.7557319223985888e-07; cp = cp * y2 + 2.4801587301587302e-05; cp = cp * y2 - 1.3888888888888889e-03; cp = cp * y2 + 4.1666666666666664e-02; cp = cp * y2 - 0.5; cp = 1.0 + y2 * cp;
    const double s = (q == 0) ? sp : (q == 1) ? cp : (q == 2) ? -sp : -cp;
    const double c = (q == 0) ? cp : (q == 1) ? -sp : (q == 2) ? -cp : sp;
    co = (float)c; si = (float)s;
}

DI void phase0(const Params& p, LDSP unsigned char* lds) {
    const int tid = otid(), G = gridDim.x, bid = obid();
    if (bid < 192) {
        LDSP float* sc = (LDSP float*)lds;
        LDSP float* red = (LDSP float*)(lds + 32768);
        for (int i = tid; i < 8 * 1024; i += 512) sc[i] = silu(p.c[i]);
        __syncthreads();
        for (int item = bid; item < 192; item += G) {
            const int l = item / 96, cg = item % 96, col = cg * 32 + (tid & 31), kg = tid >> 5;
            const float* wp = p.w_ada + ((size_t)l * 1024 + kg * 64) * 3072 + col;
            float a[8] = {0.f, 0.f, 0.f, 0.f, 0.f, 0.f, 0.f, 0.f};
            for (int k = 0; k < 64; ++k) { const float wv = wp[(size_t)k * 3072];
#pragma unroll
                for (int b = 0; b < 8; ++b) a[b] += sc[b * 1024 + kg * 64 + k] * wv; }
#pragma unroll
            for (int b = 0; b < 8; ++b) red[(kg * 8 + b) * 32 + (tid & 31)] = a[b];
            __syncthreads();
            if (tid < 256) { const int b = tid >> 5, cc = tid & 31; float s = 0.f;
                for (int q = 0; q < 16; ++q) s += red[(q * 8 + b) * 32 + cc];
                p.mod[((size_t)l * 8 + b) * 3072 + cg * 32 + cc] = s + p.b_ada[l * 3072 + cg * 32 + cc]; }
            __syncthreads();
        }
    }
    for (int e = bid * 512 + tid; e < SEQ * 64; e += G * 512) { float co, si; rope_entry(e >> 6, e & 63, co, si); p.rope[e] = make_float2(co, si); }
    LDSP float* tile = (LDSP float*)lds;
    const int NT_IN = 2 * 60 * 16, NT_OUT = 2 * 16 * 16;
    for (int item = bid; item < NT_IN + NT_OUT; item += G) {
        __syncthreads();
        const bool is_in = item < NT_IN;
        int l, nt, kt; if (is_in) { l = item / 960; const int r = item % 960; nt = r >> 4; kt = r & 15; } else { const int r2 = item - NT_IN; l = r2 >> 8; nt = (r2 >> 4) & 15; kt = r2 & 15; }
        const int nn = nt * 64 + (tid & 63);
        if (is_in) {
            int src = 0; float scale = 1.f; bool isz = false;
            if (nn < C_LA) { src = nn; scale = (nn < 256) ? 0.125f : 1.f; }
            else if (nn < C_QB) { isz = true; src = nn - C_LA; }
            else if (nn < C_VB) { const int o = nn - C_QB, grp = o >> 9, hh = (o >> 7) & 3, cp = o & 127; const int old = (cp & 1) ? 64 + (cp >> 1) : (cp >> 1);
                src = 1552 + grp * 512 + hh * 128 + old; scale = grp == 0 ? 0.08838834764831845f : 1.f; }
            else { src = nn - 240; }
            const float* wl = p.w_in + (size_t)l * 1024 * NIN;
#pragma unroll
            for (int i = 0; i < 8; ++i) { const int kl = (tid >> 6) + 8 * i, k = kt * 64 + kl; float v;
                if (!isz) v = wl[(size_t)k * NIN + src] * scale;
                else { v = 0.f; for (int r = 0; r < 16; ++r) v += wl[(size_t)k * NIN + 1536 + r] * p.w_gu[((size_t)l * 16 + r) * 256 + src]; }
                tile[kl * 65 + (tid & 63)] = v; }
        } else {
            const float* wl = p.w_out + (size_t)l * 1024 * 1024;
#pragma unroll
            for (int i = 0; i < 8; ++i) { const int kl = (tid >> 6) + 8 * i, k = kt * 64 + kl; tile[kl * 65 + (tid & 63)] = wl[(size_t)k * 1024 + nn]; }
        }
        __syncthreads();
        const int n = tid >> 3, k8 = (tid & 7) * 8;
        uint4 o; o.x = pk2(tile[(k8 + 0) * 65 + n], tile[(k8 + 1) * 65 + n]); o.y = pk2(tile[(k8 + 2) * 65 + n], tile[(k8 + 3) * 65 + n]);
        o.z = pk2(tile[(k8 + 4) * 65 + n], tile[(k8 + 5) * 65 + n]); o.w = pk2(tile[(k8 + 6) * 65 + n], tile[(k8 + 7) * 65 + n]);
        bf16_t* dst = is_in ? p.winT + ((size_t)l * NP + nt * 64 + n) * 1024 + kt * 64 + k8 : p.woutT + ((size_t)l * 1024 + nt * 64 + n) * 1024 + kt * 64 + k8;
        *(uint4*)dst = o;
    }
    __syncthreads();
}

DI void norm_pass(const Params& p, int mode) {
    const int tid = otid(), lane = tid & 63, w = tid >> 6;
    const int lprev = (mode == 2) ? 1 : 0, lcur = (mode == 0) ? 0 : 1;
    for (int row = obid() * 8 + w; row < NTOK; row += gridDim.x * 8) {
        const int b = row >> 12;
        const float* xin = (mode == 2 ? p.out : p.x) + (size_t)row * DM;
        f32x4 xv[4];
#pragma unroll
        for (int q = 0; q < 4; ++q) xv[q] = *(const f32x4*)(xin + 4 * lane + 256 * q);
        if (mode != 0) {
            const float* yr = p.yout + (size_t)row * DM; f32x4 yv[4]; float ss = 0.f;
#pragma unroll
            for (int q = 0; q < 4; ++q) { yv[q] = *(const f32x4*)(yr + 4 * lane + 256 * q);
#pragma unroll
                for (int e = 0; e < 4; ++e) ss += yv[q][e] * yv[q][e]; }
#pragma unroll
            for (int m = 1; m < 64; m <<= 1) ss += __shfl_xor(ss, m);
            const float rs = rsqrtf(ss * (1.0f / DM) + EPS);
            const float* gate = p.mod + ((size_t)lprev * 8 + b) * 3072 + 2048; const float* gp = p.g_post + lprev * DM;
#pragma unroll
            for (int q = 0; q < 4; ++q) { const f32x4 gt = *(const f32x4*)(gate + 4 * lane + 256 * q), gg = *(const f32x4*)(gp + 4 * lane + 256 * q);
#pragma unroll
                for (int e = 0; e < 4; ++e) xv[q][e] += gt[e] * (yv[q][e] * rs * gg[e]);
                *(f32x4*)(p.out + (size_t)row * DM + 4 * lane + 256 * q) = xv[q]; }
        }
        if (mode != 2) {
            float ss = 0.f;
#pragma unroll
            for (int q = 0; q < 4; ++q)
#pragma unroll
                for (int e = 0; e < 4; ++e) ss += xv[q][e] * xv[q][e];
#pragma unroll
            for (int m = 1; m < 64; m <<= 1) ss += __shfl_xor(ss, m);
            const float rs = rsqrtf(ss * (1.0f / DM) + EPS);
            const float* md = p.mod + ((size_t)lcur * 8 + b) * 3072; const float* gp = p.g_pre + lcur * DM;
#pragma unroll
            for (int q = 0; q < 4; ++q) { const int col = 4 * lane + 256 * q;
                const f32x4 sh = *(const f32x4*)(md + col), scl = *(const f32x4*)(md + 1024 + col), gg = *(const f32x4*)(gp + col);
                float hv[4];
#pragma unroll
                for (int e = 0; e < 4; ++e) hv[e] = (xv[q][e] * rs * gg[e]) * (1.0f + scl[e]) + sh[e];
                uint2 o; o.x = pk2(hv[0], hv[1]); o.y = pk2(hv[2], hv[3]);
                *(uint2*)(p.hy + (size_t)row * DM + col) = o; }
        }
    }
}

DI void attn_task(const Params& p, LDSP unsigned char* lds, int task) {
    const int tid = otid(), w = tid >> 6, lane = tid & 63, c = lane & 15, g = lane >> 4;
    const int bh = task / 96, sub = task % 96, b = bh >> 2, head = bh & 3, pat = sub >> 5, s5 = sub & 31;
    int d, r, n;
    if (pat == 0) { d = 1; r = 0; n = s5; } else if (pat == 1) { d = 4; r = s5 & 3; n = s5 >> 2; } else { d = 16; r = s5 & 15; n = s5 >> 4; }
    const bf16_t* base = p.proj + (size_t)b * SEQ * NP + head * 128;
    LDSP unsigned char* Ks = lds; LDSP unsigned char* Vs = lds + 256 * ATT_RS;
#pragma unroll
    for (int i = 0; i < 8; ++i) {
        const int ch = tid + 512 * i, row = ch >> 4, c16 = ch & 15, ci = 128 * (n - 1) + row;
        u32x4 kv = {0u, 0u, 0u, 0u}, vv = kv;
        if (ci >= 0) { const bf16_t* rp = base + (size_t)(ci * d + r) * NP + c16 * 8; kv = *(const u32x4*)(rp + C_KB); vv = *(const u32x4*)(rp + C_VB); }
        *(LDSP u32x4*)(Ks + row * ATT_RS + c16 * 16) = kv; *(LDSP u32x4*)(Vs + row * ATT_RS + c16 * 16) = vv;
    }
    const int posq = (128 * n + 16 * w + c) * d + r;
    const bf16_t* qp = base + (size_t)posq * NP + C_QB;
    bf16x8 qf[4];
#pragma unroll
    for (int s = 0; s < 4; ++s) qf[s] = *(const bf16x8*)(qp + 32 * s + 8 * g);
    __syncthreads();
    f32x4 sacc[9];
#pragma unroll
    for (int kt = 0; kt < 9; ++kt) {
        f32x4 a4 = {0.f, 0.f, 0.f, 0.f};
#pragma unroll
        for (int s = 0; s < 4; ++s) { const bf16x8 kf = *(const LDSP bf16x8*)(Ks + (16 * w + 16 * kt + c) * ATT_RS + (32 * s + 8 * g) * 2); a4 = mfma16(kf, qf[s], a4); }
        sacc[kt] = a4;
    }
    float mx = -INFINITY;
#pragma unroll
    for (int kt = 0; kt < 9; ++kt)
#pragma unroll
        for (int e = 0; e < 4; ++e) { const int rel = 16 * kt + 4 * g + e; const bool ok = (rel >= c) && (rel <= c + 128) && (n > 0 || 16 * w + rel >= 128);
            const float sv = ok ? sacc[kt][e] : -INFINITY; sacc[kt][e] = sv; mx = fmaxf(mx, sv); }
    mx = fmaxf(mx, __shfl_xor(mx, 16)); mx = fmaxf(mx, __shfl_xor(mx, 32));
    float lsum = 0.f;
#pragma unroll
    for (int kt = 0; kt < 9; ++kt)
#pragma unroll
        for (int e = 0; e < 4; ++e) { const float pv = __expf(sacc[kt][e] - mx); sacc[kt][e] = pv; lsum += pv; }
    lsum += __shfl_xor(lsum, 16); lsum += __shfl_xor(lsum, 32);
    f32x4 oacc[8];
#pragma unroll
    for (int dt = 0; dt < 8; ++dt) oacc[dt] = (f32x4){0.f, 0.f, 0.f, 0.f};
    const int q4 = c >> 2, p4 = c & 3;
#pragma unroll
    for (int s2 = 0; s2 < 5; ++s2) {
        const f32x4 zero4 = {0.f, 0.f, 0.f, 0.f};
        const bf16x8 pf = pack8(sacc[2 * s2], (2 * s2 + 1 < 9) ? sacc[(2 * s2 + 1 < 9) ? 2 * s2 + 1 : 0] : zero4);
        const int r0 = 16 * w + 32 * s2 + 4 * g + q4; int r1 = r0 + 16; r1 = r1 > 255 ? 255 : r1;
#pragma unroll
        for (int dt = 0; dt < 8; ++dt) {
            const s16x4 v0 = tr4(Vs, r0, ATT_RS, (16 * dt + 4 * p4) * 2), v1 = tr4(Vs, r1, ATT_RS, (16 * dt + 4 * p4) * 2);
            oacc[dt] = mfma16(cat8(v0, v1), pf, oacc[dt]);
        }
    }
    const float inv = 1.0f / lsum;
    const size_t orow = (size_t)pat * NTOK + (size_t)b * SEQ + posq;
    bf16_t* op = p.attO + orow * 512 + head * 128 + 4 * g;
#pragma unroll
    for (int dt = 0; dt < 8; ++dt) { uint2 o; o.x = pk2(oacc[dt][0] * inv, oacc[dt][1] * inv); o.y = pk2(oacc[dt][2] * inv, oacc[dt][3] * inv); *(uint2*)(op + 16 * dt) = o; }
    if (g == 0) p.attL[orow * 4 + head] = mx + __logf(lsum);
    __syncthreads();
}

DI void gla_cumsum(const float (&la)[8], LDSP float* segs, int dk, int seg, float (&bcum)[8], float& total) {
    float run = 0.f;
#pragma unroll
    for (int jj = 0; jj < 8; ++jj) { run += la[jj]; bcum[jj] = run; }
    segs[seg * 64 + dk] = run;
    __syncthreads();
    float pre = 0.f, tot = 0.f;
#pragma unroll
    for (int s = 0; s < 8; ++s) { const float v = segs[s * 64 + dk]; tot += v; pre += (s < seg) ? v : 0.f; }
#pragma unroll
    for (int jj = 0; jj < 8; ++jj) bcum[jj] += pre;
    total = tot;
}

DI void gla_cs_task(const Params& p, LDSP unsigned char* lds, int task) {
    const int tid = otid(), w = tid >> 6, lane = tid & 63, c = lane & 15, g = lane >> 4, dk = tid & 63, seg = tid >> 6;
    const int bh = task >> 6, n = task & 63, b = bh >> 2, h = bh & 3;
    const bf16_t* rp = p.proj + ((size_t)b * SEQ + n * 64) * NP;
    LDSP unsigned char* KeT = lds;
    LDSP unsigned char* Vg = lds + 9216;
    LDSP float* segs = (LDSP float*)(lds + 26624);
    float la[8], kk[8];
#pragma unroll
    for (int jj = 0; jj < 8; ++jj) { const bf16_t* q = rp + (size_t)(seg * 8 + jj) * NP + h * 64 + dk; la[jj] = bf2f(q[C_LA]); kk[jj] = bf2f(q[C_KA]); }
#pragma unroll
    for (int i = 0; i < 2; ++i) { const int ch = tid + 512 * i, row = ch >> 4, c16 = ch & 15;
        *(LDSP u32x4*)(Vg + row * 272 + c16 * 16) = *(const u32x4*)(rp + (size_t)row * NP + C_VA + h * 128 + c16 * 8); }
    float bc[8], total;
    gla_cumsum(la, segs, dk, seg, bc, total);
    { u32x4 o; float e[8];
#pragma unroll
      for (int jj = 0; jj < 8; ++jj) e[jj] = kk[jj] * __expf(total - bc[jj]);
      o[0] = pk2(e[0], e[1]); o[1] = pk2(e[2], e[3]); o[2] = pk2(e[4], e[5]); o[3] = pk2(e[6], e[7]);
      *(LDSP u32x4*)(KeT + dk * 144 + seg * 16) = o; }
    if (seg == 0) p.gdec[(size_t)task * 64 + dk] = __expf(total);
    __syncthreads();
    const int mt = w >> 1, nt0 = (w & 1) * 4, q4 = c >> 2, p4 = c & 3;
    f32x4 acc[4];
#pragma unroll
    for (int q = 0; q < 4; ++q) acc[q] = (f32x4){0.f, 0.f, 0.f, 0.f};
#pragma unroll
    for (int s = 0; s < 2; ++s) {
        const bf16x8 af = *(const LDSP bf16x8*)(KeT + (16 * mt + c) * 144 + (32 * s + 8 * g) * 2);
#pragma unroll
        for (int q = 0; q < 4; ++q) { const int cb = (16 * (nt0 + q) + 4 * p4) * 2;
            const s16x4 v0 = tr4(Vg, 32 * s + 8 * g + q4, 272, cb), v1 = tr4(Vg, 32 * s + 8 * g + 4 + q4, 272, cb);
            acc[q] = mfma16(af, cat8(v0, v1), acc[q]); }
    }
    float* gp = p.gst + (size_t)task * 8192;
#pragma unroll
    for (int q = 0; q < 4; ++q)
#pragma unroll
        for (int e = 0; e < 4; ++e) gp[(16 * mt + 4 * g + e) * 128 + 16 * (nt0 + q) + c] = acc[q][e];
    __syncthreads();
}

DI void gla_scan(const Params& p) {
    for (int e = obid() * 512 + otid(); e < 32 * 8192; e += gridDim.x * 512) {
        const int bh = e >> 13, kv = e & 8191, dk = kv >> 7;
        float* gp = p.gst + ((size_t)bh * 64) * 8192 + kv; const float* dp = p.gdec + (size_t)bh * 64 * 64 + dk;
        float state = 0.f;
        for (int n0 = 0; n0 < 64; n0 += 8) {
            float cs[8], dc[8];
#pragma unroll
            for (int i = 0; i < 8; ++i) { cs[i] = gp[(size_t)(n0 + i) * 8192]; dc[i] = dp[(n0 + i) * 64]; }
#pragma unroll
            for (int i = 0; i < 8; ++i) { gp[(size_t)(n0 + i) * 8192] = state; state = dc[i] * state + cs[i]; }
        }
    }
}

DI void gla_out_task(const Params& p, LDSP unsigned char* lds, int task, int layer) {
    const int tid = otid(), w = tid >> 6, lane = tid & 63, c = lane & 15, g = lane >> 4, dk = tid & 63, seg = tid >> 6;
    const int bh = task >> 6, n = task & 63, b = bh >> 2, h = bh & 3;
    const size_t row0 = (size_t)b * SEQ + n * 64;
    const bf16_t* rp = p.proj + row0 * NP;
    LDSP unsigned char* Qe = lds;
    LDSP unsigned char* Ke = lds + 9216;
    LDSP unsigned char* Vg = lds + 18432;
    LDSP unsigned char* Bf = lds + 35840;
    LDSP float* segs = (LDSP float*)(lds + 53248);
    LDSP float* ssq = (LDSP float*)(lds + 55296);
    float la[8], kk[8], qq[8];
#pragma unroll
    for (int jj = 0; jj < 8; ++jj) { const bf16_t* q = rp + (size_t)(seg * 8 + jj) * NP + h * 64 + dk; la[jj] = bf2f(q[C_LA]); kk[jj] = bf2f(q[C_KA]); qq[jj] = bf2f(q[C_QA]); }
#pragma unroll
    for (int i = 0; i < 2; ++i) { const int ch = tid + 512 * i, row = ch >> 4, c16 = ch & 15;
        *(LDSP u32x4*)(Vg + row * 272 + c16 * 16) = *(const u32x4*)(rp + (size_t)row * NP + C_VA + h * 128 + c16 * 8); }
    { const float* gp = p.gst + (size_t)task * 8192;
#pragma unroll
      for (int i = 0; i < 4; ++i) { const int e4 = tid + 512 * i, rdk = e4 >> 5, dv = (e4 & 31) * 4; const f32x4 v = *(const f32x4*)(gp + rdk * 128 + dv);
          u32x2 o; o[0] = pk2(v[0], v[1]); o[1] = pk2(v[2], v[3]); *(LDSP u32x2*)(Bf + rdk * 272 + dv * 2) = o; } }
    float bc[8], total;
    gla_cumsum(la, segs, dk, seg, bc, total);
#pragma unroll
    for (int jj = 0; jj < 8; ++jj) { const int j = seg * 8 + jj; const float eb = __expf(bc[jj]);
        *(LDSP unsigned short*)(Qe + j * 144 + dk * 2) = f2bf(qq[jj] * eb); *(LDSP unsigned short*)(Ke + j * 144 + dk * 2) = f2bf(kk[jj] / eb); }
    __syncthreads();
    const int it = w >> 1, nt0 = (w & 1) * 4, q4 = c >> 2, p4 = c & 3;
    bf16x8 qfr[2];
#pragma unroll
    for (int s = 0; s < 2; ++s) qfr[s] = *(const LDSP bf16x8*)(Qe + (16 * it + c) * 144 + (32 * s + 8 * g) * 2);
    f32x4 st[4];
#pragma unroll
    for (int jt = 0; jt < 4; ++jt) {
        f32x4 a4 = {0.f, 0.f, 0.f, 0.f};
#pragma unroll
        for (int s = 0; s < 2; ++s) { const bf16x8 kf = *(const LDSP bf16x8*)(Ke + (16 * jt + c) * 144 + (32 * s + 8 * g) * 2); a4 = mfma16(kf, qfr[s], a4); }
#pragma unroll
        for (int e = 0; e < 4; ++e) { const int j = 16 * jt + 4 * g + e, i = 16 * it + c; a4[e] = (j <= i) ? a4[e] : 0.f; }
        st[jt] = a4;
    }
    f32x4 oacc[4];
#pragma unroll
    for (int q = 0; q < 4; ++q) oacc[q] = (f32x4){0.f, 0.f, 0.f, 0.f};
#pragma unroll
    for (int s = 0; s < 2; ++s) {
        const bf16x8 sf = pack8(st[2 * s], st[2 * s + 1]);
#pragma unroll
        for (int q = 0; q < 4; ++q) { const int cb = (16 * (nt0 + q) + 4 * p4) * 2;
            const s16x4 b0 = tr4(Bf, 32 * s + 8 * g + q4, 272, cb), b1 = tr4(Bf, 32 * s + 8 * g + 4 + q4, 272, cb);
            oacc[q] = mfma16(qfr[s], cat8(b0, b1), oacc[q]);
            const s16x4 v0 = tr4(Vg, 32 * s + 4 * g + q4, 272, cb), v1 = tr4(Vg, 32 * s + 16 + 4 * g + q4, 272, cb);
            oacc[q] = mfma16(sf, cat8(v0, v1), oacc[q]); }
    }
    float ss[4];
#pragma unroll
    for (int e = 0; e < 4; ++e) { float s = 0.f;
#pragma unroll
        for (int q = 0; q < 4; ++q) s += oacc[q][e] * oacc[q][e];
        s += __shfl_xor(s, 1); s += __shfl_xor(s, 2); s += __shfl_xor(s, 4); s += __shfl_xor(s, 8); ss[e] = s; }
    if (c == 0) {
#pragma unroll
        for (int e = 0; e < 4; ++e) ssq[(16 * it + 4 * g + e) * 2 + (w & 1)] = ss[e]; }
    __syncthreads();
    const float* gg = p.g_gla + layer * 512 + h * 128;
#pragma unroll
    for (int e = 0; e < 4; ++e) { const int i = 16 * it + 4 * g + e; const float rinv = rsqrtf((ssq[i * 2] + ssq[i * 2 + 1]) * (1.0f / 128.0f) + EPS);
#pragma unroll
        for (int q = 0; q < 4; ++q) { const int dv = 16 * (nt0 + q) + c; const float z = bf2f(rp[(size_t)i * NP + C_ZA + h * 128 + dv]);
            p.hy[(row0 + i) * DM + h * 128 + dv] = f2bf(oacc[q][e] * rinv * gg[dv] * silu(z)); } }
    __syncthreads();
}

DI void attn_combine(const Params& p, int layer) {
    const int tid = otid(), lane = tid & 63, w = tid >> 6, head = lane >> 4;
    for (int row = obid() * 8 + w; row < NTOK; row += gridDim.x * 8) {
        float ls[3];
#pragma unroll
        for (int q = 0; q < 3; ++q) ls[q] = p.attL[((size_t)q * NTOK + row) * 4 + head];
        const float m = fmaxf(ls[0], fmaxf(ls[1], ls[2]));
        float wt[3], ws = 0.f;
#pragma unroll
        for (int q = 0; q < 3; ++q) { wt[q] = __expf(ls[q] - m); ws += wt[q]; }
        const float wi = 1.0f / ws;
        float o[8] = {0.f, 0.f, 0.f, 0.f, 0.f, 0.f, 0.f, 0.f};
#pragma unroll
        for (int q = 0; q < 3; ++q) { const uint4 v = *(const uint4*)(p.attO + ((size_t)q * NTOK + row) * 512 + 8 * lane); const float wq = wt[q] * wi;
            const unsigned u[4] = {v.x, v.y, v.z, v.w};
#pragma unroll
            for (int e = 0; e < 4; ++e) { o[2 * e] += wq * __uint_as_float(u[e] << 16); o[2 * e + 1] += wq * __uint_as_float(u[e] & 0xFFFF0000u); } }
        float ss = 0.f;
#pragma unroll
        for (int e = 0; e < 8; ++e) ss += o[e] * o[e];
        ss += __shfl_xor(ss, 1); ss += __shfl_xor(ss, 2); ss += __shfl_xor(ss, 4); ss += __shfl_xor(ss, 8);
        const float rinv = rsqrtf(ss * (1.0f / 128.0f) + EPS);
        const uint4 zv = *(const uint4*)(p.proj + (size_t)row * NP + C_ZB + 8 * lane); const unsigned zu[4] = {zv.x, zv.y, zv.z, zv.w};
        const float* gg = p.g_dil + layer * 512 + 8 * lane;
        float y[8];
#pragma unroll
        for (int e = 0; e < 4; ++e) { const float z0 = __uint_as_float(zu[e] << 16), z1 = __uint_as_float(zu[e] & 0xFFFF0000u);
            y[2 * e] = o[2 * e] * rinv * gg[2 * e] * silu(z0); y[2 * e + 1] = o[2 * e + 1] * rinv * gg[2 * e + 1] * silu(z1); }
        uint4 ov; ov.x = pk2(y[0], y[1]); ov.y = pk2(y[2], y[3]); ov.z = pk2(y[4], y[5]); ov.w = pk2(y[6], y[7]);
        *(uint4*)(p.hy + (size_t)row * DM + 512 + 8 * lane) = ov;
    }
}

__global__ void __launch_bounds__(512) fwd_megakernel(Params p) {
    extern __shared__ __attribute__((aligned(16))) unsigned char shm[];
    LDSP unsigned char* lds = (LDSP unsigned char*)shm;
    if (threadIdx.x == 0) *(LDSP u32x4*)(lds + LDS_BAR_OFF) = (u32x4){0u, 0u, 0u, 0u};
    __syncthreads();
    XcdBarrier xb = xcd_barrier_post(p.bar, (volatile LAS unsigned*)(lds + LDS_BAR_OFF));
    const int G = gridDim.x;
#define bid obid()
#ifndef SK_P0
    phase0(p, lds);
#endif
    xcd_barrier(xb);
    for (int l = 0; l < 2; ++l) {
#ifndef SK_NORM
        norm_pass(p, l);
#endif
        xcd_barrier(xb);
#ifndef SK_G1
        { pg8::Gemm gm; gm.A = p.hy; gm.Bt = p.winT + (size_t)l * NP * 1024; gm.M = NTOK; gm.N = NP; gm.K = 1024;
          pg8::StaticOrder S; S.init(NTOK, NP, G, bid);
          EpiProj E; E.O = p.proj; E.bgu = p.b_gu + l * 256; E.rope = p.rope;
          pg8::gemm_phase<EpiProj, pg8::StaticOrder, false>(lds, gm, S, E, nullptr); }
#endif
        xcd_barrier(xb);
#ifndef SK_ATT
        for (int t = bid; t < 3072; t += G) attn_task(p, lds, t);
#endif
#ifndef SK_CS
        for (int t = bid; t < 2048; t += G) gla_cs_task(p, lds, t);
#endif
        xcd_barrier(xb);
#ifndef SK_SCAN
        gla_scan(p);
#endif
        xcd_barrier(xb);
#ifndef SK_GO
        for (int t = bid; t < 2048; t += G) gla_out_task(p, lds, t, l);
#endif
#ifndef SK_COMB
        attn_combine(p, l);
#endif
        xcd_barrier(xb);
#ifndef SK_G2
        { pg8::Gemm gm; gm.A = p.hy; gm.Bt = p.woutT + (size_t)l * 1024 * 1024; gm.M = NTOK; gm.N = DM; gm.K = 1024;
          pg8::StaticOrder S; S.init(NTOK, DM, G, bid);
          EpiOut E; E.C = p.yout;
          pg8::gemm_phase<EpiOut, pg8::StaticOrder, false>(lds, gm, S, E, nullptr); }
#endif
        xcd_barrier(xb);
    }
    norm_pass(p, 2);
#undef bid
}
}

extern "C" void kernel_launch(void* const* d_in, const int* in_sizes, int n_in, void* d_out, int out_size, void* d_ws, size_t ws_size, hipStream_t stream) {
    using namespace mk;
    static int grid_blocks = 0;
    if (!grid_blocks) {
        int dev = 0, cus = 0, per_cu = 0;
        hipGetDevice(&dev);
        hipDeviceGetAttribute(&cus, hipDeviceAttributeMultiprocessorCount, dev);
        hipFuncSetAttribute((const void*)fwd_megakernel, hipFuncAttributeMaxDynamicSharedMemorySize, LDS_BYTES);
        hipOccupancyMaxActiveBlocksPerMultiprocessor(&per_cu, (const void*)fwd_megakernel, 512, LDS_BYTES);
        if (per_cu < 1) { fprintf(stderr, "occupancy query returned %d\n", per_cu); per_cu = 1; }
        grid_blocks = cus;
    }
    Params p{};
    p.x = (const float*)d_in[0]; p.c = (const float*)d_in[1]; p.w_ada = (const float*)d_in[2]; p.b_ada = (const float*)d_in[3];
    p.g_pre = (const float*)d_in[4]; p.w_in = (const float*)d_in[5]; p.w_gu = (const float*)d_in[6]; p.b_gu = (const float*)d_in[7];
    p.g_gla = (const float*)d_in[8]; p.g_dil = (const float*)d_in[9]; p.w_out = (const float*)d_in[10]; p.g_post = (const float*)d_in[11];
    p.out = (float*)d_out;
    unsigned char* ws = (unsigned char*)d_ws; size_t off = 0;
    auto take = [&](size_t bytes) { unsigned char* r = ws + off; off += (bytes + 255) & ~(size_t)255; return r; };
    p.bar = (unsigned*)take(XCD_BAR_WORDS * 4);
    p.mod = (float*)take((size_t)2 * 8 * 3072 * 4);
    p.rope = (float2*)take((size_t)SEQ * 64 * 8);
    p.winT = (bf16_t*)take((size_t)2 * NP * 1024 * 2);
    p.woutT = (bf16_t*)take((size_t)2 * 1024 * 1024 * 2);
    p.hy = (bf16_t*)take((size_t)NTOK * DM * 2);
    p.proj = (bf16_t*)take((size_t)NTOK * NP * 2);
    p.yout = (float*)p.proj;
    p.attO = (bf16_t*)take((size_t)3 * NTOK * 512 * 2);
    p.attL = (float*)take((size_t)3 * NTOK * 4 * 4);
    p.gst = (float*)take((size_t)2048 * 8192 * 4);
    p.gdec = (float*)take((size_t)2048 * 64 * 4);
    if (off > ws_size) fprintf(stderr, "workspace too small: need %zu have %zu\n", off, ws_size);
    hipMemsetAsync(p.bar, 0, XCD_BAR_WORDS * 4, stream);
    void* args[] = {&p};
    hipError_t e = hipLaunchCooperativeKernel((const void*)fwd_megakernel, dim3(grid_blocks), dim3(512), args, LDS_BYTES, stream);
    if (e != hipSuccess) fprintf(stderr, "cooperative launch failed: %s (grid %d)\n", hipGetErrorString(e), grid_blocks);
}
```

```cpp
#include <hip/hip_runtime.h>
#include <cstdio>
#include <cstdint>

namespace pg8 {
#define PG8_LAS __attribute__((address_space(3)))
typedef unsigned short bf16_t;
typedef short bf16x8 __attribute__((ext_vector_type(8)));
typedef float f32x4 __attribute__((ext_vector_type(4)));
typedef unsigned u32x4 __attribute__((ext_vector_type(4)));
constexpr int BM = 256, BK = 64, HALF = 128, HTB = HALF * BK * 2  , STAGE_BYTES = 8 * HTB, NXCD = 8, WGM = 6;

__host__ __device__ __forceinline__ int lds_byte(int r, int c) { const int st = (r >> 4) * 2 + (c >> 5), rr = r & 15, cc = c & 31, ob = rr * 64 + cc * 2; return st * 1024 + (ob ^ (((ob >> 9) & 1) << 5)); }
__host__ __device__ __forceinline__ void stage_rc(int b, int& R, int& C) { const int st = b / 1024, sb = b % 1024, swz = sb ^ (((sb >> 9) & 1) << 5); R = (st >> 1) * 16 + swz / 64; C = (st & 1) * 32 + (swz % 64) / 2; }
__host__ __device__ __forceinline__ int perm32(int rho) { const int n = rho >> 4, i = rho & 15; return 8 * (i >> 2) + 4 * n + (i & 3); }

struct Unit { int pm, pn; };
struct Gemm { const bf16_t* A; const bf16_t* Bt; int M, N, K; };

struct StaticOrder {
    int nM, nN, nwg, G, c, wgm;
    __host__ __device__ void init(int M, int N, int G_, int c_, int wgm_ = WGM) { nM = M / BM; nN = N / BM; nwg = nM * nN; G = G_; c = c_; wgm = wgm_; }
    __host__ __device__ bool next(int i, Unit& u) const {
        const long L = (long)i * G + c; if (L >= nwg) return false;
        int wgid = (int)L; { const int q = nwg / NXCD, r = nwg % NXCD, xcd = wgid % NXCD, off = wgid / NXCD; wgid = (xcd < r ? xcd * (q + 1) : r * (q + 1) + (xcd - r) * q) + off; }
        const int nig = wgm * nN, gid = wgid / nig, fm = gid * wgm, gsz = (nM - fm) < wgm ? (nM - fm) : wgm;
        u.pm = fm + ((wgid % nig) % gsz); u.pn = (wgid % nig) / gsz; return true;
    }
    __device__ __forceinline__ void a_ready(const Unit&) const {}
    __device__ __forceinline__ void done(const Unit&) const {}
};
__device__ __forceinline__ unsigned cvt_pk_bf16(float lo, float hi) { unsigned r; asm volatile("v_cvt_pk_bf16_f32 %0, %1, %2" : "=v"(r) : "v"(lo), "v"(hi)); return r; }
template <class Epi, class Sched, bool STAMP = false>
__device__ __forceinline__ void gemm_phase(PG8_LAS unsigned char* lds, const Gemm g, const Sched& S, const Epi& E, unsigned long long* stamps) {
    int tid_ = threadIdx.x; asm volatile("" : "+v"(tid_)); const int tid = tid_, wid = __builtin_amdgcn_readfirstlane(tid >> 6), lane = tid & 63, wr = wid >> 2, wc = wid & 3, fr = lane & 15, fq = lane >> 4;
    const int K = g.K, nt = K / BK;
    int ts_lo = 0, ts_hi = 0, nts = 0; const unsigned long long rt_entry = STAMP ? (unsigned long long)wall_clock64() : 0ull;
#define PG8_STAMP() do { if (STAMP && wid == 0 && nts < 64) { const unsigned long long _c = (unsigned long long)clock64(); \
        ts_lo = (lane == nts) ? (int)(unsigned)_c : ts_lo; ts_hi = (lane == nts) ? (int)(unsigned)(_c >> 32) : ts_hi; ++nts; } } while (0)
    PG8_STAMP();
    unsigned voffA[2], voffB[2];
#pragma unroll
    for (int i = 0; i < 2; ++i) { int R, C; stage_rc(tid * 16 + i * 8192, R, C); const int Rb = Epi::PERM ? ((R & ~31) + perm32(R & 31)) : R;
        voffA[i] = (unsigned)(R * K + C) * 2u; voffB[i] = (unsigned)(Rb * K + C) * 2u; }
    const size_t kstep = (size_t)(BK * 2);
    const size_t hstep = (size_t)HALF * K * 2;
    const size_t tstep = 2 * hstep;
    const unsigned ldsw = (unsigned)wid * 1024u;
    const int aoff = lds_byte(wr * 64 + fr, fq * 8), boff = lds_byte(wc * 32 + fr, fq * 8);
#define PG8_SA(b, h) (((b) * 2 + (h)) * HTB)
#define PG8_SB(b, h) ((4 + (b) * 2 + (h)) * HTB)
#define PG8_STAGE(bufoff, gbase, voff) do { _Pragma("unroll") for (int _i = 0; _i < 2; ++_i) \
        __builtin_amdgcn_global_load_lds((const unsigned*)((const char*)(gbase) + (voff)[_i]), (PG8_LAS unsigned*)(lds + (bufoff) + ldsw + _i * 8192), 16, 0, 0); } while (0)
#define PG8_LDA(dst, b, h) do { _Pragma("unroll") for (int m = 0; m < 4; ++m) _Pragma("unroll") for (int k = 0; k < 2; ++k) dst[m][k] = *(const PG8_LAS bf16x8*)(lds + PG8_SA(b, h) + aoff + m * 2048 + k * 1024); } while (0)
#define PG8_LDB(dst, b, h) do { _Pragma("unroll") for (int n = 0; n < 2; ++n) _Pragma("unroll") for (int k = 0; k < 2; ++k) dst[n][k] = *(const PG8_LAS bf16x8*)(lds + PG8_SB(b, h) + boff + n * 2048 + k * 1024); } while (0)
#define PG8_MMA(ai, bj, At, Bt) do { __builtin_amdgcn_s_setprio(1); _Pragma("unroll") for (int m = 0; m < 4; ++m) _Pragma("unroll") for (int n = 0; n < 2; ++n) _Pragma("unroll") for (int k = 0; k < 2; ++k) \
        acc[ai][bj][m][n] = __builtin_amdgcn_mfma_f32_16x16x32_bf16(Bt[n][k], At[m][k], acc[ai][bj][m][n], 0, 0, 0); __builtin_amdgcn_s_setprio(0); } while (0)
#define PG8_WAIT_V(n) asm volatile("s_waitcnt vmcnt(" #n ")" ::: "memory")
#define PG8_WAIT_L(n) asm volatile("s_waitcnt lgkmcnt(" #n ")" ::: "memory")
#define PG8_BAR __builtin_amdgcn_s_barrier()
#define PG8_SCHED __builtin_amdgcn_sched_barrier(0)
    Unit cur, nxt; int ui = 0;
    if (!S.next(0, cur)) return;
    f32x4 acc[2][2][4][2];
#pragma unroll
    for (int a = 0; a < 2; ++a)
#pragma unroll
        for (int b = 0; b < 2; ++b)
#pragma unroll
            for (int m = 0; m < 4; ++m)
#pragma unroll
                for (int n = 0; n < 2; ++n) acc[a][b][m][n] = (f32x4){0.f, 0.f, 0.f, 0.f};
    bf16x8 At[4][2], B0[2][2], B1[2][2];
    const char* cA = (const char*)g.A + (size_t)cur.pm * tstep; const char* cB = (const char*)g.Bt + (size_t)cur.pn * tstep;
    S.a_ready(cur);
    PG8_STAGE(PG8_SB(0, 0), cB, voffB); PG8_STAGE(PG8_SA(0, 0), cA, voffA); PG8_STAGE(PG8_SB(0, 1), cB + hstep, voffB); PG8_STAGE(PG8_SA(0, 1), cA + hstep, voffA);
    if (wr == 1) PG8_BAR;
    PG8_WAIT_V(4); PG8_BAR;
    PG8_STAGE(PG8_SB(1, 0), cB + kstep, voffB); PG8_STAGE(PG8_SA(1, 0), cA + kstep, voffA); PG8_STAGE(PG8_SB(1, 1), cB + hstep + kstep, voffB);
    PG8_WAIT_V(6); PG8_BAR;
    PG8_STAMP();
    for (;;) {
        const bool has_next = S.next(ui + 1, nxt);
        const char* nA = has_next ? (const char*)g.A + (size_t)nxt.pm * tstep : cA; const char* nB = has_next ? (const char*)g.Bt + (size_t)nxt.pn * tstep : cB;
        for (int t = 0; t < nt; t += 2) {
            const bool last = (t == nt - 2);
            const char* a1 = cA + (size_t)(t + 1) * kstep;
            const char* a2 = last ? nA : cA + (size_t)(t + 2) * kstep; const char* b2 = last ? nB : cB + (size_t)(t + 2) * kstep;
            const char* a3 = a2 + kstep; const char* b3 = b2 + kstep;
            if (last && has_next) S.a_ready(nxt);
            PG8_LDB(B0, 0, 0); PG8_SCHED; PG8_LDA(At, 0, 0); PG8_STAGE(PG8_SA(1, 1), a1 + hstep, voffA);
            PG8_WAIT_L(8); PG8_BAR; PG8_WAIT_L(0); PG8_MMA(0, 0, At, B0); PG8_BAR; PG8_SCHED;
            PG8_LDB(B1, 0, 1); PG8_STAGE(PG8_SB(0, 0), b2, voffB);
            PG8_BAR; PG8_WAIT_L(0); PG8_MMA(0, 1, At, B1); PG8_BAR;
            PG8_LDA(At, 0, 1); PG8_STAGE(PG8_SA(0, 0), a2, voffA);
            PG8_BAR; PG8_WAIT_L(0); PG8_MMA(1, 0, At, B0); PG8_BAR; PG8_SCHED;
            PG8_STAGE(PG8_SB(0, 1), b2 + hstep, voffB);
            PG8_WAIT_V(6); PG8_BAR; PG8_MMA(1, 1, At, B1); PG8_BAR;
            PG8_LDB(B0, 1, 0); PG8_SCHED; PG8_LDA(At, 1, 0); PG8_STAGE(PG8_SA(0, 1), a2 + hstep, voffA);
            PG8_WAIT_L(8); PG8_BAR; PG8_WAIT_L(0); PG8_MMA(0, 0, At, B0); PG8_BAR; PG8_SCHED;
            PG8_LDB(B1, 1, 1); PG8_STAGE(PG8_SB(1, 0), b3, voffB);
            PG8_BAR; PG8_WAIT_L(0); PG8_MMA(0, 1, At, B1); PG8_BAR;
            PG8_LDA(At, 1, 1); PG8_STAGE(PG8_SA(1, 0), a3, voffA);
            PG8_BAR; PG8_WAIT_L(0); PG8_MMA(1, 0, At, B0); PG8_BAR; PG8_SCHED;
            PG8_STAGE(PG8_SB(1, 1), b3 + hstep, voffB);
            PG8_WAIT_V(6); PG8_BAR; PG8_MMA(1, 1, At, B1); PG8_BAR;
        }
        PG8_STAMP();
        if constexpr (!Epi::AFTER_DRAIN) { E(acc, cur, wr, wc, fr, fq); S.done(cur); }
        PG8_STAMP();
        if (!has_next) break;
#pragma unroll
        for (int a = 0; a < 2; ++a)
#pragma unroll
            for (int b = 0; b < 2; ++b)
#pragma unroll
                for (int m = 0; m < 4; ++m)
#pragma unroll
                    for (int n = 0; n < 2; ++n) acc[a][b][m][n] = (f32x4){0.f, 0.f, 0.f, 0.f};
        cur = nxt; cA = nA; cB = nB; ++ui;
    }
    PG8_WAIT_V(0);
    if (wr == 0) PG8_BAR;
    PG8_BAR;
    if constexpr (Epi::AFTER_DRAIN) { E.fused(acc, cur, wr, wc, fr, fq, lds, wid, lane); S.done(cur); }
    PG8_STAMP();
    if (STAMP && wid == 0) { stamps[lane] = lane < nts ? (((unsigned long long)(unsigned)ts_hi << 32) | (unsigned)ts_lo) : 0ull;
        if (lane == 62) stamps[62] = rt_entry; if (lane == 63) stamps[63] = (unsigned long long)wall_clock64(); }
#undef PG8_STAMP
#undef PG8_SA
#undef PG8_SB
#undef PG8_STAGE
#undef PG8_LDA
#undef PG8_LDB
#undef PG8_MMA
#undef PG8_WAIT_V
#undef PG8_WAIT_L
#undef PG8_BAR
#undef PG8_SCHED
}
}
#define XB_TMO      128
#define XB_XCNT(j)  (256  + 64 * (j))
#define XB_XSUB(j)  (1280 + 64 * (j))
#define XB_XGEN(j)  (2304 + 64 * (j))
#define XB_TOP      3328
#define XB_TOPGEN   3392
#define XCD_BAR_WORDS 3456
#define XB_SPIN_CAP (1u << 18)
#define LAS __attribute__((address_space(3)))

__device__ __forceinline__ unsigned xb_ld(unsigned* p)              { return __hip_atomic_load(p, __ATOMIC_RELAXED, __HIP_MEMORY_SCOPE_AGENT); }
__device__ __forceinline__ unsigned xb_add(unsigned* p, unsigned v) { return __hip_atomic_fetch_add(p, v, __ATOMIC_RELAXED, __HIP_MEMORY_SCOPE_AGENT); }
__device__ __forceinline__ unsigned xb_xcc_id() { return (unsigned)__builtin_amdgcn_s_getreg((3 << 11) | 20) & 0xFu; }
#define XB_SPIN(cond, bar) do { unsigned _sp = 0; while (cond) { __builtin_amdgcn_s_sleep(1); \
    if ((++_sp & 255u) == 0u) { if (xb_ld(&(bar)[XB_TMO])) break; if (_sp > XB_SPIN_CAP) { atomicAdd(&(bar)[XB_TMO], 1u); break; } } } } while (0)

struct XcdBarrier {
    unsigned* bar; unsigned x;
    volatile LAS unsigned* st;
};

__device__ __forceinline__ XcdBarrier xcd_barrier_post(unsigned* bar, volatile LAS unsigned* st) {
    XcdBarrier b; b.bar = bar; b.x = xb_xcc_id(); b.st = st;
    if (threadIdx.x == 0) (void)xb_add(&bar[XB_XCNT(b.x)], 1u);
    return b;
}
__device__ __forceinline__ void xcd_barrier_complete(unsigned* bar, unsigned x, unsigned& nloc, unsigned& nx) {
    const unsigned G = gridDim.x * gridDim.y * gridDim.z;
    unsigned sum, cnt, mine, sp = 0u;
    for (;;) {
        sum = 0u; cnt = 0u; mine = 0u;
#pragma unroll
        for (unsigned j = 0; j < 16; ++j) { const unsigned c = xb_ld(&bar[XB_XCNT(j)]); sum += c; cnt += (c > 0u) ? 1u : 0u; mine = (j == x) ? c : mine; }
        if (sum == G) break;
        __builtin_amdgcn_s_sleep(1);
        if ((++sp & 255u) == 0u) { if (xb_ld(&bar[XB_TMO])) break; if (sp > XB_SPIN_CAP) { atomicAdd(&bar[XB_TMO], 1u); break; } }
    }
    nloc = mine > 0u ? mine : 1u; nx = cnt > 0u ? cnt : 1u;
}

__device__ __forceinline__ void xcd_barrier(const XcdBarrier& b) {
    asm volatile("s_waitcnt vmcnt(0)" ::: "memory");
    __syncthreads();
    if (threadIdx.x == 0) {
        unsigned* bar = b.bar; unsigned bx = b.x; asm volatile("" : "+s"(bx));
        __builtin_amdgcn_s_waitcnt(0);
        unsigned nloc = b.st[0], nx = b.st[1];
        if (nloc == 0u) { xcd_barrier_complete(bar, bx, nloc, nx); b.st[0] = nloc; b.st[1] = nx; }
        const unsigned old = xb_add(&bar[XB_XSUB(bx)], 1u);
        const unsigned gen = old / nloc;
        if (old + 1u == (gen + 1u) * nloc) {
            __builtin_amdgcn_fence(__ATOMIC_RELEASE, "agent");
            asm volatile("s_waitcnt vmcnt(0)" ::: "memory");
            const unsigned og = xb_add(&bar[XB_TOP], 1u);
            const unsigned tg = og / nx;
            if (og + 1u == (tg + 1u) * nx) xb_add(&bar[XB_TOPGEN], 1u);
            else XB_SPIN(xb_ld(&bar[XB_TOPGEN]) == tg, bar);
            __builtin_amdgcn_fence(__ATOMIC_ACQUIRE, "agent");
            xb_add(&bar[XB_XGEN(bx)], 1u);
            asm volatile("s_waitcnt vmcnt(0)" ::: "memory");
        } else {
            XB_SPIN(xb_ld(&bar[XB_XGEN(bx)]) == gen, bar);
            __builtin_amdgcn_fence(__ATOMIC_ACQUIRE, "agent");
            asm volatile("s_waitcnt vmcnt(0)" ::: "memory");
        }
    }
    __syncthreads();
}
namespace mk {
using pg8::bf16_t; using pg8::bf16x8; using pg8::f32x4;
typedef short s16x4 __attribute__((ext_vector_type(4)));
typedef unsigned u32x4 __attribute__((ext_vector_type(4)));
typedef unsigned u32x2 __attribute__((ext_vector_type(2)));
#define LDSP __attribute__((address_space(3)))
#define DI __device__ __forceinline__
DI int otid() { int t = threadIdx.x; asm volatile("" : "+v"(t)); return t; }
DI int obid() { int t = blockIdx.x; asm volatile("" : "+s"(t)); return t; }

constexpr int NB = 8, SEQ = 4096, DM = 1024, NTOK = NB * SEQ, NP = 3584, NIN = 3600;
constexpr int C_QA = 0, C_KA = 256, C_VA = 512, C_ZA = 1024, C_QB = 1536, C_KB = 2048, C_VB = 2560, C_ZB = 3072;
constexpr float EPS = 1e-6f;
constexpr int ATT_RS = 304;
constexpr int LDS_BAR_OFF = 131072;
constexpr int LDS_BYTES = LDS_BAR_OFF + 64;

struct Params {
    const float *x, *c, *w_ada, *b_ada, *g_pre, *w_in, *w_gu, *b_gu, *g_gla, *g_dil, *w_out, *g_post;
    float* out;
    unsigned* bar; float* mod; float2* rope; bf16_t* winT; bf16_t* woutT; bf16_t* hy; bf16_t* proj; bf16_t* yout;
    bf16_t* attO; float* attL; bf16_t* gst; float* gdec; bf16_t* wlrT; bf16_t* lab;
};

DI float bf2f(unsigned short b) { return __uint_as_float(((unsigned)b) << 16); }
typedef __bf16 hbf2 __attribute__((ext_vector_type(2)));
typedef float hf2 __attribute__((ext_vector_type(2)));
DI unsigned pk2(float lo, float hi) { hf2 v = {lo, hi}; return __builtin_bit_cast(unsigned, __builtin_convertvector(v, hbf2)); }
DI unsigned short f2bf(float f) { return (unsigned short)(pk2(f, 0.f) & 0xFFFFu); }
DI float silu(float v) { return v / (1.0f + __expf(-v)); }
DI f32x4 mfma16(bf16x8 a, bf16x8 b, f32x4 c) { return __builtin_amdgcn_mfma_f32_16x16x32_bf16(a, b, c, 0, 0, 0); }
DI s16x4 tr4(LDSP unsigned char* base, int row, int rs, int colbyte) {
    return __builtin_amdgcn_ds_read_tr16_b64_v4i16((LDSP s16x4*)(base + row * rs + colbyte));
}
DI bf16x8 cat8(s16x4 a, s16x4 b) { return __builtin_shufflevector(a, b, 0, 1, 2, 3, 4, 5, 6, 7); }
DI bf16x8 pack8(f32x4 a, f32x4 b) {
    typedef unsigned u32x4 __attribute__((ext_vector_type(4)));
    u32x4 r; r[0] = pk2(a[0], a[1]); r[1] = pk2(a[2], a[3]); r[2] = pk2(b[0], b[1]); r[3] = pk2(b[2], b[3]);
    return __builtin_bit_cast(bf16x8, r);
}

struct EpiProj {
    static constexpr bool PERM = true, AFTER_DRAIN = false;
    bf16_t* O; const float2* rope;
    DI void store8(bf16_t* p, f32x4 v0, f32x4 v1) const {
        uint4 o; o.x = pk2(v0[0], v0[1]); o.y = pk2(v0[2], v0[3]); o.z = pk2(v1[0], v1[1]); o.w = pk2(v1[2], v1[3]);
        *(uint4*)p = o;
    }
    DI void operator()(const f32x4 (&acc)[2][2][4][2], const pg8::Unit& u, int wr, int wc, int fr, int fq) const {
        const int row0 = u.pm * 256 + wr * 64 + fr, col0 = u.pn * 256 + wc * 32 + 8 * fq;
        if (u.pn >= 6 && u.pn <= 9) {
            const int j0 = 16 * wc + 4 * fq;
#pragma unroll
            for (int ai = 0; ai < 2; ++ai)
#pragma unroll
                for (int m = 0; m < 4; ++m) {
                    const int row = row0 + ai * 128 + m * 16, pos = row & (SEQ - 1);
                    const f32x4 t0 = *(const f32x4*)(rope + pos * 64 + j0), t1 = *(const f32x4*)(rope + pos * 64 + j0 + 2);
                    bf16_t* rowp = O + (size_t)row * NP + col0;
#pragma unroll
                    for (int bj = 0; bj < 2; ++bj) {
                        const f32x4 a0 = acc[ai][bj][m][0], a1 = acc[ai][bj][m][1]; f32x4 v0, v1;
                        v0[0] = a0[0] * t0[0] - a0[1] * t0[1]; v0[1] = a0[1] * t0[0] + a0[0] * t0[1];
                        v0[2] = a0[2] * t0[2] - a0[3] * t0[3]; v0[3] = a0[3] * t0[2] + a0[2] * t0[3];
                        v1[0] = a1[0] * t1[0] - a1[1] * t1[1]; v1[1] = a1[1] * t1[0] + a1[0] * t1[1];
                        v1[2] = a1[2] * t1[2] - a1[3] * t1[3]; v1[3] = a1[3] * t1[2] + a1[2] * t1[3];
                        store8(rowp + bj * 128, v0, v1);
                    }
                }
        } else {
#pragma unroll
            for (int ai = 0; ai < 2; ++ai)
#pragma unroll
                for (int m = 0; m < 4; ++m) {
                    bf16_t* rowp = O + (size_t)(row0 + ai * 128 + m * 16) * NP + col0;
#pragma unroll
                    for (int bj = 0; bj < 2; ++bj) store8(rowp + bj * 128, acc[ai][bj][m][0], acc[ai][bj][m][1]);
                }
        }
    }
};
struct EpiOut {
    static constexpr bool PERM = true, AFTER_DRAIN = false;
    bf16_t* C; int ldc;
    DI void operator()(const f32x4 (&acc)[2][2][4][2], const pg8::Unit& u, int wr, int wc, int fr, int fq) const {
        const int row0 = u.pm * 256 + wr * 64 + fr, col0 = u.pn * 256 + wc * 32 + 8 * fq;
#pragma unroll
        for (int ai = 0; ai < 2; ++ai)
#pragma unroll
            for (int m = 0; m < 4; ++m) { bf16_t* rowp = C + (size_t)(row0 + ai * 128 + m * 16) * ldc + col0;
#pragma unroll
                for (int bj = 0; bj < 2; ++bj) { const f32x4 v0 = acc[ai][bj][m][0], v1 = acc[ai][bj][m][1];
                    u32x4 o; o[0] = pk2(v0[0], v0[1]); o[1] = pk2(v0[2], v0[3]); o[2] = pk2(v1[0], v1[1]); o[3] = pk2(v1[2], v1[3]);
                    *(u32x4*)(rowp + bj * 128) = o; } }
    }
};

DI void rope_entry(int pos, int j, float& co, float& si) {
    const double invd = exp2(-(double)(2 * j) * (13.287712379549449 / 128.0));
    const float invf = (float)invd, angf = (float)pos * invf;
    const double a = (double)angf, k = rint(a * 0.6366197723675814);
    double y = fma(-k, 1.5707963267948966, a); y = fma(-k, 6.123233995736766e-17, y);
    const int q = ((int)k) & 3; const double y2 = y * y;
    double sp = -2.5052108385441720e-08; sp = sp * y2 + 2.7557319223985893e-06; sp = sp * y2 - 1.9841269841269841e-04; sp = sp * y2 + 8.3333333333333332e-03; sp = sp * y2 - 1.6666666666666666e-01; sp = y + y * y2 * sp;
    double cp = 2.0876756987868100e-09; cp = cp * y2 - 2.7557319223985888e-07; cp = cp * y2 + 2.4801587301587302e-05; cp = cp * y2 - 1.3888888888888889e-03; cp = cp * y2 + 4.1666666666666664e-02; cp = cp * y2 - 0.5; cp = 1.0 + y2 * cp;
    const double s = (q == 0) ? sp : (q == 1) ? cp : (q == 2) ? -sp : -cp;
    const double c = (q == 0) ? cp : (q == 1) ? -sp : (q == 2) ? -cp : sp;
    co = (float)c; si = (float)s;
}

DI void phase0(const Params& p, LDSP unsigned char* lds) {
    const int tid = otid(), G = gridDim.x, bid = obid();
    if (bid < 192) {
        LDSP float* sc = (LDSP float*)lds;
        LDSP float* red = (LDSP float*)(lds + 32768);
        for (int i = tid; i < 8 * 1024; i += 512) sc[i] = silu(p.c[i]);
        __syncthreads();
        for (int item = bid; item < 192; item += G) {
            const int l = item / 96, cg = item % 96, col = cg * 32 + (tid & 31), kg = tid >> 5;
            const float* wp = p.w_ada + ((size_t)l * 1024 + kg * 64) * 3072 + col;
            float a[8] = {0.f, 0.f, 0.f, 0.f, 0.f, 0.f, 0.f, 0.f};
#pragma unroll
            for (int k0 = 0; k0 < 64; k0 += 32) { float wv[32];
#pragma unroll
                for (int k = 0; k < 32; ++k) wv[k] = wp[(size_t)(k0 + k) * 3072];
#pragma unroll
                for (int k = 0; k < 32; ++k)
#pragma unroll
                    for (int b = 0; b < 8; ++b) a[b] += sc[b * 1024 + kg * 64 + k0 + k] * wv[k]; }
#pragma unroll
            for (int b = 0; b < 8; ++b) red[(kg * 8 + b) * 32 + (tid & 31)] = a[b];
            __syncthreads();
            if (tid < 256) { const int b = tid >> 5, cc = tid & 31; float s = 0.f;
                for (int q = 0; q < 16; ++q) s += red[(q * 8 + b) * 32 + cc];
                p.mod[((size_t)l * 8 + b) * 3072 + cg * 32 + cc] = s + p.b_ada[l * 3072 + cg * 32 + cc]; }
            __syncthreads();
        }
    }
    for (int e = bid * 512 + tid; e < SEQ * 64; e += G * 512) { float co, si; rope_entry(e >> 6, e & 63, co, si); p.rope[e] = make_float2(co, si); }
    for (int e = bid * 512 + tid; e < 2 * 16 * 1024; e += G * 512) { const int l = e >> 14, r = (e >> 10) & 15, k = e & 1023; p.wlrT[e] = f2bf(p.w_in[((size_t)l * 1024 + k) * NIN + 1536 + r]); }
}

DI void phase0c(const Params& p, LDSP unsigned char* lds) {
    const int tid = otid(), G = gridDim.x, bid = obid();
    LDSP float* tile = (LDSP float*)lds;
    const int NT_IN = 2 * 56 * 4, NT_OUT = 2 * 16 * 4;
    for (int item = bid; item < NT_IN + NT_OUT; item += G) {
        __syncthreads();
        const bool is_in = item < NT_IN;
        int l, nt, kq; if (is_in) { l = item / 224; const int r = item % 224; nt = r >> 2; kq = r & 3; } else { const int r2 = item - NT_IN; l = r2 >> 6; nt = (r2 >> 2) & 15; kq = r2 & 3; }
        const int nn = nt * 64 + (tid & 63);
        const float* src; size_t ld; float scale = 1.f;
        if (is_in) {
            int sc = 0;
            if (nn < C_QB) { sc = nn; scale = (nn < 256) ? 0.125f : 1.f; }
            else if (nn < C_VB) { const int o = nn - C_QB, grp = o >> 9, hh = (o >> 7) & 3, cp = o & 127; const int old = (cp & 1) ? 64 + (cp >> 1) : (cp >> 1);
                sc = 1552 + grp * 512 + hh * 128 + old; scale = grp == 0 ? 0.08838834764831845f : 1.f; }
            else { sc = nn + 16; }
            src = p.w_in + (size_t)l * 1024 * NIN + sc; ld = NIN;
        } else { src = p.w_out + (size_t)l * 1024 * 1024 + nn; ld = 1024; }
        src += (size_t)(kq * 256 + (tid >> 6)) * ld;
#pragma unroll
        for (int i0 = 0; i0 < 32; i0 += 8) { float v[8];
#pragma unroll
            for (int i = 0; i < 8; ++i) v[i] = src[(size_t)(8 * (i0 + i)) * ld];
#pragma unroll
            for (int i = 0; i < 8; ++i) tile[((tid >> 6) + 8 * (i0 + i)) * 65 + (tid & 63)] = v[i] * scale; }
        __syncthreads();
#pragma unroll
        for (int q = 0; q < 4; ++q) { const int ch = tid + 512 * q, n = ch >> 5, k8 = (ch & 31) * 8;
            u32x4 o; o[0] = pk2(tile[(k8 + 0) * 65 + n], tile[(k8 + 1) * 65 + n]); o[1] = pk2(tile[(k8 + 2) * 65 + n], tile[(k8 + 3) * 65 + n]);
            o[2] = pk2(tile[(k8 + 4) * 65 + n], tile[(k8 + 5) * 65 + n]); o[3] = pk2(tile[(k8 + 6) * 65 + n], tile[(k8 + 7) * 65 + n]);
            bf16_t* dst = is_in ? p.winT + ((size_t)l * NP + nt * 64 + n) * 1024 + kq * 256 + k8 : p.woutT + ((size_t)l * 1024 + nt * 64 + n) * 1024 + kq * 256 + k8;
            *(u32x4*)dst = o; }
    }
    __syncthreads();
}

DI void norm_pass(const Params& p, int mode) {
    const int tid = otid(), lane = tid & 63, w = tid >> 6, stride = gridDim.x * 8;
    const bf16_t* y0 = (const bf16_t*)p.out + 1024;
    for (int rowa = obid() * 8 + w; rowa < NTOK; rowa += 2 * stride) {
        int rows[2]; rows[0] = rowa; rows[1] = (rowa + stride < NTOK) ? rowa + stride : rowa;
        const bool dup = rows[1] == rows[0];
        f32x4 xv[2][4]; u32x4 yv[2][2], yw[2][2];
#pragma unroll
        for (int u = 0; u < 2; ++u) {
            const float* xin = p.x + (size_t)rows[u] * DM + 8 * lane;
#pragma unroll
            for (int q = 0; q < 2; ++q) { xv[u][2 * q] = *(const f32x4*)(xin + 512 * q); xv[u][2 * q + 1] = *(const f32x4*)(xin + 512 * q + 4); }
            if (mode != 0) {
#pragma unroll
                for (int q = 0; q < 2; ++q) yv[u][q] = *(const u32x4*)(y0 + (size_t)rows[u] * 2048 + 512 * q + 8 * lane); }
            if (mode == 2) {
#pragma unroll
                for (int q = 0; q < 2; ++q) yw[u][q] = *(const u32x4*)(p.yout + (size_t)rows[u] * DM + 512 * q + 8 * lane); }
        }
#pragma unroll
        for (int u = 0; u < 2; ++u) {
            const int row = rows[u], b = row >> 12;
#pragma unroll
            for (int lp = 0; lp < 2; ++lp) {
                if ((lp == 0 && mode != 0) || (lp == 1 && mode == 2)) {
                    float yf[16]; float ss = 0.f;
#pragma unroll
                    for (int q = 0; q < 2; ++q)
#pragma unroll
                        for (int e = 0; e < 4; ++e) { const unsigned uu = lp ? yw[u][q][e] : yv[u][q][e]; yf[8 * q + 2 * e] = __uint_as_float(uu << 16); yf[8 * q + 2 * e + 1] = __uint_as_float(uu & 0xFFFF0000u); }
#pragma unroll
                    for (int e = 0; e < 16; ++e) ss += yf[e] * yf[e];
#pragma unroll
                    for (int m = 1; m < 64; m <<= 1) ss += __shfl_xor(ss, m);
                    const float rs = rsqrtf(ss * (1.0f / DM) + EPS);
                    const float* gate = p.mod + ((size_t)lp * 8 + b) * 3072 + 2048 + 8 * lane; const float* gp = p.g_post + lp * DM + 8 * lane;
#pragma unroll
                    for (int q = 0; q < 4; ++q) { const int co = 512 * (q >> 1) + 4 * (q & 1); const f32x4 gt = *(const f32x4*)(gate + co), gg = *(const f32x4*)(gp + co);
#pragma unroll
                        for (int e = 0; e < 4; ++e) xv[u][q][e] += gt[e] * (yf[4 * q + e] * rs * gg[e]); }
                }
            }
            if (mode == 2) {
                if (!(u == 1 && dup)) {
#pragma unroll
                    for (int q = 0; q < 4; ++q) { const int co = 512 * (q >> 1) + 4 * (q & 1); *(f32x4*)(p.out + (size_t)row * DM + 8 * lane + co) = xv[u][q]; } }
            } else {
                const int lcur = mode;
                float ss = 0.f;
#pragma unroll
                for (int q = 0; q < 4; ++q)
#pragma unroll
                    for (int e = 0; e < 4; ++e) ss += xv[u][q][e] * xv[u][q][e];
#pragma unroll
                for (int m = 1; m < 64; m <<= 1) ss += __shfl_xor(ss, m);
                const float rs = rsqrtf(ss * (1.0f / DM) + EPS);
                const float* md = p.mod + ((size_t)lcur * 8 + b) * 3072 + 8 * lane; const float* gp = p.g_pre + lcur * DM + 8 * lane;
#pragma unroll
                for (int q = 0; q < 2; ++q) { float hv[8];
#pragma unroll
                    for (int hf = 0; hf < 2; ++hf) { const int co = 512 * q + 4 * hf;
                        const f32x4 sh = *(const f32x4*)(md + co), scl = *(const f32x4*)(md + 1024 + co), gg = *(const f32x4*)(gp + co);
#pragma unroll
                        for (int e = 0; e < 4; ++e) hv[4 * hf + e] = (xv[u][2 * q + hf][e] * rs * gg[e]) * (1.0f + scl[e]) + sh[e]; }
                    u32x4 o; o[0] = pk2(hv[0], hv[1]); o[1] = pk2(hv[2], hv[3]); o[2] = pk2(hv[4], hv[5]); o[3] = pk2(hv[6], hv[7]);
                    *(u32x4*)(p.hy + (size_t)row * DM + 512 * q + 8 * lane) = o; }
            }
        }
    }
}

DI void lr_phase(const Params& p, LDSP unsigned char* lds, int layer) {
    const int tid = otid(), w = tid >> 6, lane = tid & 63, c = lane & 15, g = lane >> 4, G = gridDim.x;
    LDSP float* lrs = (LDSP float*)lds;
    LDSP unsigned char* wlr = lds + 10240;
    for (int i = tid; i < 2048; i += 512) { const int r = i >> 7, ch = i & 127; *(LDSP u32x4*)(wlr + r * 2064 + ch * 16) = *(const u32x4*)(p.wlrT + (size_t)layer * 16384 + r * 1024 + ch * 8); }
    f32x4 wv[16];
#pragma unroll
    for (int r = 0; r < 16; ++r) wv[r] = *(const f32x4*)(p.w_gu + (size_t)layer * 4096 + r * 256 + 4 * lane);
    const f32x4 bias = *(const f32x4*)(p.b_gu + layer * 256 + 4 * lane);
    for (int slab = obid(); slab < NTOK / 128; slab += G) {
        const bf16_t* hp = p.hy + ((size_t)slab * 128 + 16 * w + c) * DM + 8 * g;
        bf16x8 a[32];
#pragma unroll
        for (int s = 0; s < 32; ++s) a[s] = *(const bf16x8*)(hp + 32 * s);
        __syncthreads();
        f32x4 acc0 = {0.f, 0.f, 0.f, 0.f}, acc1 = acc0;
#pragma unroll
        for (int s = 0; s < 32; s += 2) {
            acc0 = mfma16(a[s], *(const LDSP bf16x8*)(wlr + c * 2064 + (32 * s + 8 * g) * 2), acc0);
            acc1 = mfma16(a[s + 1], *(const LDSP bf16x8*)(wlr + c * 2064 + (32 * (s + 1) + 8 * g) * 2), acc1);
        }
#pragma unroll
        for (int e = 0; e < 4; ++e) lrs[(16 * w + 4 * g + e) * 20 + c] = acc0[e] + acc1[e];
        __syncthreads();
        bf16_t* op = p.lab + ((size_t)slab * 128 + 16 * w) * 256 + 4 * lane;
#pragma unroll 4
        for (int tk = 0; tk < 16; ++tk) {
            const LDSP float* lp = lrs + (16 * w + tk) * 20;
            const f32x4 l0 = *(const LDSP f32x4*)lp, l1 = *(const LDSP f32x4*)(lp + 4), l2 = *(const LDSP f32x4*)(lp + 8), l3 = *(const LDSP f32x4*)(lp + 12);
            f32x4 z = bias;
#pragma unroll
            for (int r = 0; r < 4; ++r) { z += wv[r] * l0[r]; z += wv[4 + r] * l1[r]; z += wv[8 + r] * l2[r]; z += wv[12 + r] * l3[r]; }
#pragma unroll
            for (int e = 0; e < 4; ++e) z[e] = (fminf(z[e], 0.f) - __logf(1.0f + __expf(-fabsf(z[e])))) * 0.0625f;
            u32x2 o; o[0] = pk2(z[0], z[1]); o[1] = pk2(z[2], z[3]);
            *(u32x2*)(op + (size_t)tk * 256) = o;
        }
    }
    __syncthreads();
}

struct A2Task { int b, head, pat, d, r, n2; };
DI A2Task a2_decode(int task) {
    A2Task t; const int bh = task / 48, sub = task % 48, s4 = sub & 15; t.b = bh >> 2; t.head = bh & 3; t.pat = sub >> 4;
    if (t.pat == 0) { t.d = 1; t.r = 0; t.n2 = s4; } else if (t.pat == 1) { t.d = 4; t.r = s4 & 3; t.n2 = s4 >> 2; } else { t.d = 16; t.r = s4; t.n2 = 0; }
    return t;
}
DI void a2_issue_rows(const Params& p, const A2Task& t, int tid_in, int coff, u32x4 (&R)[12]) {
    int tid = tid_in; asm volatile("" : "+v"(tid));
    const bf16_t* base = p.proj + (size_t)t.b * SEQ * NP + t.head * 128 + coff;
#pragma unroll
    for (int i = 0; i < 12; ++i) {
        const int ch = tid + 512 * i, row = ch >> 4, c16 = ch & 15, ci = 256 * t.n2 - 128 + row;
        u32x4 v = {0u, 0u, 0u, 0u};
        if (ci >= 0) v = *(const u32x4*)(base + (size_t)(ci * t.d + t.r) * NP + c16 * 8);
        R[i] = v;
    }
}
DI void a2_issue_q(const Params& p, const A2Task& t, int tid_in, bf16x8 (&Q)[2][4]) {
    int tid = tid_in; asm volatile("" : "+v"(tid));
    const int w = tid >> 6, lane = tid & 63, c = lane & 15, g = lane >> 4;
    const bf16_t* base = p.proj + (size_t)t.b * SEQ * NP + t.head * 128 + C_QB + 8 * g;
#pragma unroll
    for (int qt = 0; qt < 2; ++qt) { const int posq = (256 * t.n2 + 32 * w + 16 * qt + c) * t.d + t.r;
#pragma unroll
        for (int s = 0; s < 4; ++s) Q[qt][s] = *(const bf16x8*)(base + (size_t)posq * NP + 32 * s); }
}
DI void attn2_phase(const Params& p, LDSP unsigned char* lds) {
    const int tid = otid(), w = tid >> 6, lane = tid & 63, c = lane & 15, g = lane >> 4, G = gridDim.x;
    LDSP unsigned char* Ls = lds;
    const int bid0 = obid(), xcd = bid0 & 7, local = bid0 >> 3;
    const int nx = (G >= 8) ? 8 : G, per = (32 / nx) * 48, nwl = (G - xcd + 7) >> 3;
#define A2_TASK(i) ((xcd * (32 / nx) + (i) / 48) * 48 + (i) % 48)
    u32x4 kr[12], vr[12]; bf16x8 qn[2][4];
    int it = local;
    if (it < per) { const A2Task t0 = a2_decode(A2_TASK(it)); a2_issue_rows(p, t0, tid, C_KB, kr); a2_issue_q(p, t0, tid, qn); }
    for (; it < per; it += nwl) {
        const A2Task t = a2_decode(A2_TASK(it));
{ int t2 = tid; asm volatile("" : "+v"(t2)); LDSP unsigned char* wb = Ls + (t2 >> 4) * ATT_RS + (t2 & 15) * 16;
#pragma unroll
        for (int i = 0; i < 12; ++i) *(LDSP u32x4*)(wb + i * 32 * ATT_RS) = kr[i]; }
        bf16x8 qf[2][4];
#pragma unroll
        for (int qt = 0; qt < 2; ++qt)
#pragma unroll
            for (int s = 0; s < 4; ++s) qf[qt][s] = qn[qt][s];
        __syncthreads();
        a2_issue_rows(p, t, tid, C_VB, vr);
        f32x4 sA[9], sB[9];
        {
            const LDSP unsigned char* kbase = Ls + (32 * w + c) * ATT_RS + 16 * g;
#define A2_LDK(dst, kt) _Pragma("unroll") for (int s = 0; s < 4; ++s) dst[s] = *(const LDSP bf16x8*)(kbase + (kt) * 16 * ATT_RS + 64 * s)
#define A2_SB __builtin_amdgcn_sched_barrier(0)
#define A2_MM(K, kt) do { f32x4 x0 = {0.f, 0.f, 0.f, 0.f}, x1 = x0; \
            _Pragma("unroll") for (int s = 0; s < 4; ++s) { if ((kt) <= 8) x0 = mfma16(K[s], qf[0][s], x0); if ((kt) >= 1) x1 = mfma16(K[s], qf[1][s], x1); } \
            if ((kt) <= 8) sA[(kt) <= 8 ? (kt) : 0] = x0; if ((kt) >= 1) sB[(kt) >= 1 ? (kt) - 1 : 0] = x1; } while (0)
            bf16x8 ka[4], kb[4];
            A2_LDK(ka, 0); A2_SB;
            A2_LDK(kb, 1); A2_SB; A2_MM(ka, 0); A2_SB;
            A2_LDK(ka, 2); A2_SB; A2_MM(kb, 1); A2_SB;
            A2_LDK(kb, 3); A2_SB; A2_MM(ka, 2); A2_SB;
            A2_LDK(ka, 4); A2_SB; A2_MM(kb, 3); A2_SB;
            A2_LDK(kb, 5); A2_SB; A2_MM(ka, 4); A2_SB;
            A2_LDK(ka, 6); A2_SB; A2_MM(kb, 5); A2_SB;
            A2_LDK(kb, 7); A2_SB; A2_MM(ka, 6); A2_SB;
            A2_LDK(ka, 8); A2_SB; A2_MM(kb, 7); A2_SB;
            A2_LDK(kb, 9); A2_SB; A2_MM(ka, 8); A2_SB;
            A2_MM(kb, 9);
        }
#pragma unroll
        for (int e = 0; e < 4; ++e) { const bool lo = (4 * g + e >= c), hi = (4 * g + e <= c);
            sA[0][e] = lo ? sA[0][e] : -INFINITY; sA[8][e] = hi ? sA[8][e] : -INFINITY; sB[0][e] = lo ? sB[0][e] : -INFINITY; sB[8][e] = hi ? sB[8][e] : -INFINITY; }
        if (t.n2 == 0) {
#pragma unroll
            for (int j = 0; j < 9; ++j)
#pragma unroll
                for (int e = 0; e < 4; ++e) { sA[j][e] = (32 * w + 16 * j + 4 * g + e >= 128) ? sA[j][e] : -INFINITY; sB[j][e] = (32 * w + 16 * (j + 1) + 4 * g + e >= 128) ? sB[j][e] : -INFINITY; }
        }
        float mxA = -INFINITY, mxB = -INFINITY;
#pragma unroll
        for (int j = 0; j < 9; ++j)
#pragma unroll
            for (int e = 0; e < 4; ++e) { mxA = fmaxf(mxA, sA[j][e]); mxB = fmaxf(mxB, sB[j][e]); }
        mxA = fmaxf(mxA, __shfl_xor(mxA, 16)); mxA = fmaxf(mxA, __shfl_xor(mxA, 32)); mxB = fmaxf(mxB, __shfl_xor(mxB, 16)); mxB = fmaxf(mxB, __shfl_xor(mxB, 32));
        float lsA = 0.f, lsB = 0.f;
#pragma unroll
        for (int j = 0; j < 9; ++j)
#pragma unroll
            for (int e = 0; e < 4; ++e) { const float pa = __expf(sA[j][e] - mxA), pb = __expf(sB[j][e] - mxB); sA[j][e] = pa; sB[j][e] = pb; lsA += pa; lsB += pb; }
        lsA += __shfl_xor(lsA, 16); lsA += __shfl_xor(lsA, 32); lsB += __shfl_xor(lsB, 16); lsB += __shfl_xor(lsB, 32);
        bf16x8 pfA[5], pfB[5];
        { const f32x4 zero4 = {0.f, 0.f, 0.f, 0.f};
#pragma unroll
          for (int s = 0; s < 4; ++s) pfA[s] = pack8(sA[2 * s], sA[2 * s + 1]);
          pfA[4] = pack8(sA[8], zero4);
          pfB[0] = pack8(zero4, sB[0]);
#pragma unroll
          for (int s = 1; s < 5; ++s) pfB[s] = pack8(sB[2 * s - 1], sB[2 * s]); }
        __syncthreads();
{ int t2 = tid; asm volatile("" : "+v"(t2)); LDSP unsigned char* wb = Ls + (t2 >> 4) * ATT_RS + (t2 & 15) * 16;
#pragma unroll
        for (int i = 0; i < 12; ++i) *(LDSP u32x4*)(wb + i * 32 * ATT_RS) = vr[i]; }
        __syncthreads();
        if (it + nwl < per) { const A2Task tn = a2_decode(A2_TASK(it + nwl)); a2_issue_rows(p, tn, tid, C_KB, kr); a2_issue_q(p, tn, tid, qn); }
        f32x4 oA[8], oB[8];
#pragma unroll
        for (int dt = 0; dt < 8; ++dt) { oA[dt] = (f32x4){0.f, 0.f, 0.f, 0.f}; oB[dt] = oA[dt]; }
        {
            const int q4 = c >> 2, p4 = c & 3, rb = 32 * w + 4 * g + q4;
#define A2_LDV(dst, bt) do { const int r0_ = rb + 32 * ((bt) >> 1), r1_ = r0_ + 16; \
            _Pragma("unroll") for (int d = 0; d < 4; ++d) { const int cb_ = (16 * (4 * ((bt) & 1) + d) + 4 * p4) * 2; dst[d] = cat8(tr4(Ls, r0_, ATT_RS, cb_), tr4(Ls, r1_, ATT_RS, cb_)); } } while (0)
#define A2_MMV(src, bt) _Pragma("unroll") for (int d = 0; d < 4; ++d) { oA[4 * ((bt) & 1) + d] = mfma16(src[d], pfA[(bt) >> 1], oA[4 * ((bt) & 1) + d]); oB[4 * ((bt) & 1) + d] = mfma16(src[d], pfB[(bt) >> 1], oB[4 * ((bt) & 1) + d]); }
            bf16x8 va[4], vb[4];
            A2_LDV(va, 0); A2_SB;
            A2_LDV(vb, 1); A2_SB; A2_MMV(va, 0); A2_SB;
            A2_LDV(va, 2); A2_SB; A2_MMV(vb, 1); A2_SB;
            A2_LDV(vb, 3); A2_SB; A2_MMV(va, 2); A2_SB;
            A2_LDV(va, 4); A2_SB; A2_MMV(vb, 3); A2_SB;
            A2_LDV(vb, 5); A2_SB; A2_MMV(va, 4); A2_SB;
            A2_LDV(va, 6); A2_SB; A2_MMV(vb, 5); A2_SB;
            A2_LDV(vb, 7); A2_SB; A2_MMV(va, 6); A2_SB;
            A2_LDV(va, 8); A2_SB; A2_MMV(vb, 7); A2_SB;
            A2_LDV(vb, 9); A2_SB; A2_MMV(va, 8); A2_SB;
            A2_MMV(vb, 9);
        }
        __syncthreads();
        {
            const float invA = 1.0f / lsA, invB = 1.0f / lsB;
            LDSP unsigned char* st = Ls + w * (32 * ATT_RS);
#pragma unroll
            for (int dt = 0; dt < 8; ++dt) { u32x2 o; o[0] = pk2(oA[dt][0] * invA, oA[dt][1] * invA); o[1] = pk2(oA[dt][2] * invA, oA[dt][3] * invA); *(LDSP u32x2*)(st + c * ATT_RS + (16 * dt + 4 * g) * 2) = o;
                u32x2 o2; o2[0] = pk2(oB[dt][0] * invB, oB[dt][1] * invB); o2[1] = pk2(oB[dt][2] * invB, oB[dt][3] * invB); *(LDSP u32x2*)(st + (16 + c) * ATT_RS + (16 * dt + 4 * g) * 2) = o2; }
            const size_t tokbase = (size_t)t.pat * NTOK + (size_t)t.b * SEQ;
#pragma unroll 2
            for (int k = 0; k < 8; ++k) { const int id = lane + 64 * k, row = id >> 4, c16 = id & 15;
                const u32x4 v = *(const LDSP u32x4*)(st + row * ATT_RS + c16 * 16);
                const int pos = (256 * t.n2 + 32 * w + row) * t.d + t.r;
                *(u32x4*)(p.attO + (tokbase + pos) * 512 + t.head * 128 + c16 * 8) = v; }
            if (g == 0) { const int posA = (256 * t.n2 + 32 * w + c) * t.d + t.r, posB = posA + 16 * t.d;
                p.attL[(tokbase + posA) * 4 + t.head] = mxA + __logf(lsA); p.attL[(tokbase + posB) * 4 + t.head] = mxB + __logf(lsB); }
        }
        __syncthreads();
    }
}

DI void gla_cumsum(const float (&la)[8], LDSP float* segs, int dk, int seg, float (&bcum)[8], float& total) {
    float run = 0.f;
#pragma unroll
    for (int jj = 0; jj < 8; ++jj) { run += la[jj]; bcum[jj] = run; }
    segs[seg * 64 + dk] = run;
    __syncthreads();
    float pre = 0.f, tot = 0.f;
#pragma unroll
    for (int s = 0; s < 8; ++s) { const float v = segs[s * 64 + dk]; tot += v; pre += (s < seg) ? v : 0.f; }
#pragma unroll
    for (int jj = 0; jj < 8; ++jj) bcum[jj] += pre;
    total = tot;
}

constexpr int GL_LA = 0, GL_KK = 9216, GL_QQ = 18432, GL_VG = 27648, GL_BF = 45056, GL_ZT = 62464, GL_SEG = 79872, GL_SSQ = 81920, GL_OST = 82432;
struct CsPre { u32x4 la, k, v[2]; };
DI void cs_issue(const Params& p, int task, int tid, CsPre& R) {
    const int bh = task >> 6, n = task & 63, b = bh >> 2, h = bh & 3;
    const bf16_t* rp = p.proj + ((size_t)b * SEQ + n * 64) * NP;
    { const bf16_t* q = rp + (size_t)(tid >> 3) * NP + h * 64 + (tid & 7) * 8; R.la = *(const u32x4*)(p.lab + ((size_t)b * SEQ + n * 64 + (tid >> 3)) * 256 + h * 64 + (tid & 7) * 8); R.k = *(const u32x4*)(q + C_KA); }
#pragma unroll
    for (int i = 0; i < 2; ++i) { const int ch = tid + 512 * i; R.v[i] = *(const u32x4*)(rp + (size_t)(ch >> 4) * NP + C_VA + h * 128 + (ch & 15) * 8); }
}
DI void gla_cs_phase(const Params& p, LDSP unsigned char* lds) {
    const int tid = otid(), w = tid >> 6, lane = tid & 63, c = lane & 15, g = lane >> 4, dk = tid & 63, seg = tid >> 6, G = gridDim.x;
    LDSP unsigned char* LA = lds + GL_LA; LDSP unsigned char* KK = lds + GL_KK; LDSP unsigned char* KeT = lds + GL_QQ; LDSP unsigned char* Vg = lds + GL_VG;
    LDSP float* segs = (LDSP float*)(lds + GL_SEG);
    int task = obid(); CsPre R;
    if (task < 2048) cs_issue(p, task, tid, R);
    for (; task < 2048; task += G) {
        *(LDSP u32x4*)(LA + (tid >> 3) * 144 + (tid & 7) * 16) = R.la; *(LDSP u32x4*)(KK + (tid >> 3) * 144 + (tid & 7) * 16) = R.k;
#pragma unroll
        for (int i = 0; i < 2; ++i) { const int ch = tid + 512 * i; *(LDSP u32x4*)(Vg + (ch >> 4) * 272 + (ch & 15) * 16) = R.v[i]; }
        __syncthreads();
        if (task + G < 2048) cs_issue(p, task + G, tid, R);
        float la[8], kk[8];
#pragma unroll
        for (int jj = 0; jj < 8; ++jj) { const int j = seg * 8 + jj; la[jj] = bf2f(*(const LDSP unsigned short*)(LA + j * 144 + dk * 2)); kk[jj] = bf2f(*(const LDSP unsigned short*)(KK + j * 144 + dk * 2)); }
        float bc[8], total;
        gla_cumsum(la, segs, dk, seg, bc, total);
        { u32x4 o; float e[8];
#pragma unroll
          for (int jj = 0; jj < 8; ++jj) e[jj] = kk[jj] * __expf(total - bc[jj]);
          o[0] = pk2(e[0], e[1]); o[1] = pk2(e[2], e[3]); o[2] = pk2(e[4], e[5]); o[3] = pk2(e[6], e[7]);
          *(LDSP u32x4*)(KeT + dk * 144 + seg * 16) = o; }
        if (seg == 0) p.gdec[(size_t)task * 64 + dk] = __expf(total);
        __syncthreads();
        const int mt = w >> 1, nt0 = (w & 1) * 4, q4 = c >> 2, p4 = c & 3;
        f32x4 acc[4];
#pragma unroll
        for (int q = 0; q < 4; ++q) acc[q] = (f32x4){0.f, 0.f, 0.f, 0.f};
#pragma unroll
        for (int s = 0; s < 2; ++s) {
            const bf16x8 af = *(const LDSP bf16x8*)(KeT + (16 * mt + c) * 144 + (32 * s + 8 * g) * 2);
#pragma unroll
            for (int q = 0; q < 4; ++q) { const int cb = (16 * (nt0 + q) + 4 * p4) * 2;
                const s16x4 v0 = tr4(Vg, 32 * s + 8 * g + q4, 272, cb), v1 = tr4(Vg, 32 * s + 8 * g + 4 + q4, 272, cb);
                acc[q] = mfma16(cat8(v0, v1), af, acc[q]); }
        }
        bf16_t* gp = p.gst + (size_t)task * 8192 + (16 * mt + c) * 128 + 4 * g;
#pragma unroll
        for (int q = 0; q < 4; ++q) { u32x2 o; o[0] = pk2(acc[q][0], acc[q][1]); o[1] = pk2(acc[q][2], acc[q][3]); *(u32x2*)(gp + 16 * (nt0 + q)) = o; }
        __syncthreads();
    }
}

DI void gla_scan(const Params& p, bf16_t* dst) {
    const int tid = otid(), lane = tid & 63, seg = lane >> 4, gw = obid() * 8 + (tid >> 6), nw = gridDim.x * 8;
    for (int wi = gw; wi < 4096; wi += nw) {
        const int q = wi * 16 + (lane & 15), bh = q >> 11, kv4 = q & 2047, dk = kv4 >> 5;
        const size_t off = ((size_t)bh * 64 + seg * 16) * 8192 + kv4 * 4;
        const bf16_t* gp = p.gst + off; bf16_t* wp = dst + off; const float* dp = p.gdec + ((size_t)bh * 64 + seg * 16) * 64 + dk;
        u32x2 cs[16]; float dc[16];
#pragma unroll
        for (int i = 0; i < 16; ++i) { cs[i] = *(const u32x2*)(gp + (size_t)i * 8192); dc[i] = dp[i * 64]; }
        f32x4 loc[16]; float pp[16];
        f32x4 st = {0.f, 0.f, 0.f, 0.f}; float P = 1.f;
#pragma unroll
        for (int i = 0; i < 16; ++i) { loc[i] = st; pp[i] = P;
            const f32x4 cv = {__uint_as_float(cs[i][0] << 16), __uint_as_float(cs[i][0] & 0xFFFF0000u), __uint_as_float(cs[i][1] << 16), __uint_as_float(cs[i][1] & 0xFFFF0000u)};
            st = st * dc[i] + cv; P *= dc[i]; }
        f32x4 carry = {0.f, 0.f, 0.f, 0.f}, mine = carry;
#pragma unroll
        for (int sgi = 0; sgi < 3; ++sgi) { const int src = (lane & 15) + 16 * sgi;
            f32x4 S; S[0] = __shfl(st[0], src); S[1] = __shfl(st[1], src); S[2] = __shfl(st[2], src); S[3] = __shfl(st[3], src); const float Ps = __shfl(P, src);
            carry = carry * Ps + S; mine = (seg == sgi + 1) ? carry : mine; }
#pragma unroll
        for (int i = 0; i < 16; ++i) { const f32x4 o = loc[i] + mine * pp[i]; u32x2 ov; ov[0] = pk2(o[0], o[1]); ov[1] = pk2(o[2], o[3]); *(u32x2*)(wp + (size_t)i * 8192) = ov; }
    }
}

struct GoPre { u32x4 la, k, q, v[2], z[2], bf[2]; };
DI void go_issue(const Params& p, int task, int tid, GoPre& R) {
    const int bh = task >> 6, n = task & 63, b = bh >> 2, h = bh & 3;
    const bf16_t* rp = p.proj + ((size_t)b * SEQ + n * 64) * NP;
    { const bf16_t* q = rp + (size_t)(tid >> 3) * NP + h * 64 + (tid & 7) * 8; R.la = *(const u32x4*)(p.lab + ((size_t)b * SEQ + n * 64 + (tid >> 3)) * 256 + h * 64 + (tid & 7) * 8); R.k = *(const u32x4*)(q + C_KA); R.q = *(const u32x4*)(q + C_QA); }
#pragma unroll
    for (int i = 0; i < 2; ++i) { const int ch = tid + 512 * i; const bf16_t* q = rp + (size_t)(ch >> 4) * NP + h * 128 + (ch & 15) * 8; R.v[i] = *(const u32x4*)(q + C_VA); R.z[i] = *(const u32x4*)(q + C_ZA); }
    const bf16_t* gp = p.gst + (size_t)task * 8192;
#pragma unroll
    for (int i = 0; i < 2; ++i) R.bf[i] = *(const u32x4*)(gp + (tid + 512 * i) * 8);
}
DI void gla_out_phase(const Params& p, LDSP unsigned char* lds, int layer) {
    const int tid = otid(), w = tid >> 6, lane = tid & 63, c = lane & 15, g = lane >> 4, dk = tid & 63, seg = tid >> 6, G = gridDim.x;
    LDSP unsigned char* LA = lds + GL_LA; LDSP unsigned char* Ke = lds + GL_KK; LDSP unsigned char* Qe = lds + GL_QQ; LDSP unsigned char* Vg = lds + GL_VG;
    LDSP unsigned char* Bf = lds + GL_BF; LDSP unsigned char* Zt = lds + GL_ZT; LDSP unsigned char* Ost = lds + GL_OST;
    LDSP float* segs = (LDSP float*)(lds + GL_SEG); LDSP float* ssq = (LDSP float*)(lds + GL_SSQ);
    int task = obid(); GoPre R;
    if (task < 2048) go_issue(p, task, tid, R);
    for (; task < 2048; task += G) {
        const int bh = task >> 6, n = task & 63, b = bh >> 2, h = bh & 3;
        const size_t row0 = (size_t)b * SEQ + n * 64;
        { const int o = (tid >> 3) * 144 + (tid & 7) * 16; *(LDSP u32x4*)(LA + o) = R.la; *(LDSP u32x4*)(Ke + o) = R.k; *(LDSP u32x4*)(Qe + o) = R.q; }
#pragma unroll
        for (int i = 0; i < 2; ++i) { const int ch = tid + 512 * i, o = (ch >> 4) * 272 + (ch & 15) * 16; *(LDSP u32x4*)(Vg + o) = R.v[i]; *(LDSP u32x4*)(Zt + o) = R.z[i]; }
#pragma unroll
        for (int i = 0; i < 2; ++i) { const int e8 = tid + 512 * i; *(LDSP u32x4*)(Bf + (e8 >> 4) * 272 + (e8 & 15) * 16) = R.bf[i]; }
        __syncthreads();
        if (task + G < 2048) go_issue(p, task + G, tid, R);
        float la[8], kk[8], qq[8];
#pragma unroll
        for (int jj = 0; jj < 8; ++jj) { const int o = (seg * 8 + jj) * 144 + dk * 2; la[jj] = bf2f(*(const LDSP unsigned short*)(LA + o)); kk[jj] = bf2f(*(const LDSP unsigned short*)(Ke + o)); qq[jj] = bf2f(*(const LDSP unsigned short*)(Qe + o)); }
        float bc[8], total;
        gla_cumsum(la, segs, dk, seg, bc, total);
#pragma unroll
        for (int jj = 0; jj < 8; ++jj) { const int o = (seg * 8 + jj) * 144 + dk * 2; const float eb = __expf(bc[jj]), ebi = __expf(-bc[jj]);
            *(LDSP unsigned short*)(Qe + o) = f2bf(qq[jj] * eb); *(LDSP unsigned short*)(Ke + o) = f2bf(kk[jj] * ebi); }
        __syncthreads();
        const int it = w >> 1, nt0 = (w & 1) * 4, q4 = c >> 2, p4 = c & 3;
        bf16x8 qfr[2];
#pragma unroll
        for (int s = 0; s < 2; ++s) qfr[s] = *(const LDSP bf16x8*)(Qe + (16 * it + c) * 144 + (32 * s + 8 * g) * 2);
        f32x4 st[4];
#pragma unroll
        for (int jt = 0; jt < 4; ++jt) {
            f32x4 a4 = {0.f, 0.f, 0.f, 0.f};
#pragma unroll
            for (int s = 0; s < 2; ++s) { const bf16x8 kf = *(const LDSP bf16x8*)(Ke + (16 * jt + c) * 144 + (32 * s + 8 * g) * 2); a4 = mfma16(kf, qfr[s], a4); }
#pragma unroll
            for (int e = 0; e < 4; ++e) { const int j = 16 * jt + 4 * g + e, i = 16 * it + c; a4[e] = (j <= i) ? a4[e] : 0.f; }
            st[jt] = a4;
        }
        f32x4 oacc[4];
#pragma unroll
        for (int q = 0; q < 4; ++q) oacc[q] = (f32x4){0.f, 0.f, 0.f, 0.f};
#pragma unroll
        for (int s = 0; s < 2; ++s) {
            const bf16x8 sf = pack8(st[2 * s], st[2 * s + 1]);
#pragma unroll
            for (int q = 0; q < 4; ++q) { const int cb = (16 * (nt0 + q) + 4 * p4) * 2;
                const s16x4 b0 = tr4(Bf, 32 * s + 8 * g + q4, 272, cb), b1 = tr4(Bf, 32 * s + 8 * g + 4 + q4, 272, cb);
                oacc[q] = mfma16(cat8(b0, b1), qfr[s], oacc[q]);
                const s16x4 v0 = tr4(Vg, 32 * s + 4 * g + q4, 272, cb), v1 = tr4(Vg, 32 * s + 16 + 4 * g + q4, 272, cb);
                oacc[q] = mfma16(cat8(v0, v1), sf, oacc[q]); }
        }
        { float sq = 0.f;
#pragma unroll
          for (int q = 0; q < 4; ++q)
#pragma unroll
              for (int e = 0; e < 4; ++e) sq += oacc[q][e] * oacc[q][e];
          sq += __shfl_xor(sq, 16); sq += __shfl_xor(sq, 32);
          if (g == 0) ssq[(16 * it + c) * 2 + (w & 1)] = sq; }
        __syncthreads();
        { const int i = 16 * it + c; const float rinv = rsqrtf((ssq[i * 2] + ssq[i * 2 + 1]) * (1.0f / 128.0f) + EPS);
#pragma unroll
          for (int q = 0; q < 4; ++q) *(LDSP f32x4*)(Ost + i * 528 + (16 * (nt0 + q) + 4 * g) * 4) = oacc[q] * rinv; }
        __syncthreads();
        const float* gg = p.g_gla + layer * 512 + h * 128;
#pragma unroll
        for (int i2 = 0; i2 < 2; ++i2) { const int ch = tid + 512 * i2, row = ch >> 4, c16 = ch & 15;
            const f32x4 o0 = *(const LDSP f32x4*)(Ost + row * 528 + c16 * 32), o1 = *(const LDSP f32x4*)(Ost + row * 528 + c16 * 32 + 16);
            const u32x4 zv = *(const LDSP u32x4*)(Zt + row * 272 + c16 * 16);
            const f32x4 g0 = *(const f32x4*)(gg + c16 * 8), g1 = *(const f32x4*)(gg + c16 * 8 + 4);
            float y[8];
#pragma unroll
            for (int e = 0; e < 2; ++e) { y[2 * e] = o0[2 * e] * g0[2 * e] * silu(__uint_as_float(zv[e] << 16)); y[2 * e + 1] = o0[2 * e + 1] * g0[2 * e + 1] * silu(__uint_as_float(zv[e] & 0xFFFF0000u)); }
#pragma unroll
            for (int e = 0; e < 2; ++e) { y[4 + 2 * e] = o1[2 * e] * g1[2 * e] * silu(__uint_as_float(zv[2 + e] << 16)); y[5 + 2 * e] = o1[2 * e + 1] * g1[2 * e + 1] * silu(__uint_as_float(zv[2 + e] & 0xFFFF0000u)); }
            u32x4 ov; ov[0] = pk2(y[0], y[1]); ov[1] = pk2(y[2], y[3]); ov[2] = pk2(y[4], y[5]); ov[3] = pk2(y[6], y[7]);
            *(u32x4*)(p.hy + (row0 + row) * DM + h * 128 + c16 * 8) = ov; }
        __syncthreads();
    }
}

DI void attn_combine(const Params& p, int layer) {
    const int tid = otid(), lane = tid & 63, w = tid >> 6, head = lane >> 4, stride = gridDim.x * 8;
    for (int rowa = obid() * 8 + w; rowa < NTOK; rowa += 2 * stride) {
        int rows[2]; rows[0] = rowa; rows[1] = (rowa + stride < NTOK) ? rowa + stride : rowa;
        float ls[2][3]; u32x4 ov3[2][3], zv[2];
#pragma unroll
        for (int u = 0; u < 2; ++u) {
#pragma unroll
            for (int q = 0; q < 3; ++q) { ls[u][q] = p.attL[((size_t)q * NTOK + rows[u]) * 4 + head]; ov3[u][q] = *(const u32x4*)(p.attO + ((size_t)q * NTOK + rows[u]) * 512 + 8 * lane); }
            zv[u] = *(const u32x4*)(p.proj + (size_t)rows[u] * NP + C_ZB + 8 * lane);
        }
        const float* gg = p.g_dil + layer * 512 + 8 * lane;
        const f32x4 g0 = *(const f32x4*)gg, g1 = *(const f32x4*)(gg + 4);
#pragma unroll
        for (int u = 0; u < 2; ++u) {
            const float m = fmaxf(ls[u][0], fmaxf(ls[u][1], ls[u][2]));
            float wt[3], ws = 0.f;
#pragma unroll
            for (int q = 0; q < 3; ++q) { wt[q] = __expf(ls[u][q] - m); ws += wt[q]; }
            const float wi = 1.0f / ws;
            float o[8] = {0.f, 0.f, 0.f, 0.f, 0.f, 0.f, 0.f, 0.f};
#pragma unroll
            for (int q = 0; q < 3; ++q) { const float wq = wt[q] * wi;
#pragma unroll
                for (int e = 0; e < 4; ++e) { o[2 * e] += wq * __uint_as_float(ov3[u][q][e] << 16); o[2 * e + 1] += wq * __uint_as_float(ov3[u][q][e] & 0xFFFF0000u); } }
            float ss = 0.f;
#pragma unroll
            for (int e = 0; e < 8; ++e) ss += o[e] * o[e];
            ss += __shfl_xor(ss, 1); ss += __shfl_xor(ss, 2); ss += __shfl_xor(ss, 4); ss += __shfl_xor(ss, 8);
            const float rinv = rsqrtf(ss * (1.0f / 128.0f) + EPS);
            float y[8];
#pragma unroll
            for (int e = 0; e < 4; ++e) { const float z0 = __uint_as_float(zv[u][e] << 16), z1 = __uint_as_float(zv[u][e] & 0xFFFF0000u);
                const float ga = (e < 2) ? g0[2 * e] : g1[2 * e - 4], gb = (e < 2) ? g0[2 * e + 1] : g1[2 * e - 3];
                y[2 * e] = o[2 * e] * rinv * ga * silu(z0); y[2 * e + 1] = o[2 * e + 1] * rinv * gb * silu(z1); }
            u32x4 ov; ov[0] = pk2(y[0], y[1]); ov[1] = pk2(y[2], y[3]); ov[2] = pk2(y[4], y[5]); ov[3] = pk2(y[6], y[7]);
            *(u32x4*)(p.hy + (size_t)rows[u] * DM + 512 + 8 * lane) = ov;
        }
    }
}

__global__ void __launch_bounds__(512) fwd_megakernel(Params p) {
    extern __shared__ __attribute__((aligned(16))) unsigned char shm[];
    LDSP unsigned char* lds = (LDSP unsigned char*)shm;
    if (threadIdx.x == 0) *(LDSP u32x4*)(lds + LDS_BAR_OFF) = (u32x4){0u, 0u, 0u, 0u};
    __syncthreads();
    XcdBarrier xb = xcd_barrier_post(p.bar, (volatile LAS unsigned*)(lds + LDS_BAR_OFF));
    const int G = gridDim.x;
    phase0(p, lds);
    xcd_barrier(xb);
    for (int l = 0; l < 2; ++l) {
        if (l == 0) phase0c(p, lds);
        norm_pass(p, l);
        xcd_barrier(xb);
        { pg8::Gemm gm; gm.A = p.hy; gm.Bt = p.winT + (size_t)l * NP * 1024; gm.M = NTOK; gm.N = NP; gm.K = 1024;
          pg8::StaticOrder S; S.init(NTOK, NP, G, obid());
          EpiProj E; E.O = p.proj; E.rope = p.rope;
          pg8::gemm_phase<EpiProj, pg8::StaticOrder, false>(lds, gm, S, E, nullptr); }
        lr_phase(p, lds, l);
        xcd_barrier(xb);
        attn2_phase(p, lds);
        gla_cs_phase(p, lds);
        xcd_barrier(xb);
        gla_scan(p, p.gst);
        xcd_barrier(xb);
        if ((obid() >> 3) % 3 == 0) { attn_combine(p, l); gla_out_phase(p, lds, l); } else { gla_out_phase(p, lds, l); attn_combine(p, l); }
        xcd_barrier(xb);
        { pg8::Gemm gm; gm.A = p.hy; gm.Bt = p.woutT + (size_t)l * 1024 * 1024; gm.M = NTOK; gm.N = DM; gm.K = 1024;
          pg8::StaticOrder S; S.init(NTOK, DM, G, obid());
          EpiOut E; E.C = l ? p.yout : (bf16_t*)p.out + 1024; E.ldc = l ? DM : 2048;
          pg8::gemm_phase<EpiOut, pg8::StaticOrder, false>(lds, gm, S, E, nullptr); }
        xcd_barrier(xb);
    }
    norm_pass(p, 2);
}
}

extern "C" void kernel_launch(void* const* d_in, const int* in_sizes, int n_in, void* d_out, int out_size, void* d_ws, size_t ws_size, hipStream_t stream) {
    using namespace mk;
    static int grid_blocks = 0;
    if (!grid_blocks) {
        int dev = 0, cus = 0, per_cu = 0;
        hipGetDevice(&dev);
        hipDeviceGetAttribute(&cus, hipDeviceAttributeMultiprocessorCount, dev);
        hipFuncSetAttribute((const void*)fwd_megakernel, hipFuncAttributeMaxDynamicSharedMemorySize, LDS_BYTES);
        hipOccupancyMaxActiveBlocksPerMultiprocessor(&per_cu, (const void*)fwd_megakernel, 512, LDS_BYTES);
        if (per_cu < 1) { fprintf(stderr, "occupancy query returned %d\n", per_cu); per_cu = 1; }
        grid_blocks = cus;
    }
    Params p{};
    p.x = (const float*)d_in[0]; p.c = (const float*)d_in[1]; p.w_ada = (const float*)d_in[2]; p.b_ada = (const float*)d_in[3];
    p.g_pre = (const float*)d_in[4]; p.w_in = (const float*)d_in[5]; p.w_gu = (const float*)d_in[6]; p.b_gu = (const float*)d_in[7];
    p.g_gla = (const float*)d_in[8]; p.g_dil = (const float*)d_in[9]; p.w_out = (const float*)d_in[10]; p.g_post = (const float*)d_in[11];
    p.out = (float*)d_out;
    unsigned char* ws = (unsigned char*)d_ws; size_t off = 0;
    auto take = [&](size_t bytes) { unsigned char* r = ws + off; off += (bytes + 255) & ~(size_t)255; return r; };
    p.bar = (unsigned*)take(XCD_BAR_WORDS * 4);
    p.mod = (float*)take((size_t)2 * 8 * 3072 * 4);
    p.rope = (float2*)take((size_t)SEQ * 64 * 8);
    p.winT = (bf16_t*)take((size_t)2 * NP * 1024 * 2);
    p.woutT = (bf16_t*)take((size_t)2 * 1024 * 1024 * 2);
    p.hy = (bf16_t*)take((size_t)NTOK * DM * 2);
    p.proj = (bf16_t*)take((size_t)NTOK * NP * 2);
    p.yout = p.proj;
    p.attO = (bf16_t*)take((size_t)3 * NTOK * 512 * 2);
    p.attL = (float*)take((size_t)3 * NTOK * 4 * 4);
    p.gst = (bf16_t*)take((size_t)2048 * 8192 * 2);
    p.gdec = (float*)take((size_t)2048 * 64 * 4);
    p.wlrT = (bf16_t*)take((size_t)2 * 16 * 1024 * 2);
    p.lab = (bf16_t*)take((size_t)NTOK * 256 * 2);
    if (off > ws_size) fprintf(stderr, "workspace too small: need %zu have %zu\n", off, ws_size);
    hipMemsetAsync(p.bar, 0, XCD_BAR_WORDS * 4, stream);
    void* args[] = {&p};
    hipError_t e = hipLaunchCooperativeKernel((const void*)fwd_megakernel, dim3(grid_blocks), dim3(512), args, LDS_BYTES, stream);
    if (e != hipSuccess) fprintf(stderr, "cooperative launch failed: %s (grid %d)\n", hipGetErrorString(e), grid_blocks);
}
```

```cpp
#include <hip/hip_runtime.h>
#include <cstdio>
#include <cstdint>

namespace pg8 {
#define PG8_LAS __attribute__((address_space(3)))
typedef unsigned short bf16_t;
typedef short bf16x8 __attribute__((ext_vector_type(8)));
typedef float f32x4 __attribute__((ext_vector_type(4)));
typedef unsigned u32x4 __attribute__((ext_vector_type(4)));
constexpr int BM = 256, BK = 64, HALF = 128, HTB = HALF * BK * 2  , STAGE_BYTES = 8 * HTB, NXCD = 8, WGM = 6;

__host__ __device__ __forceinline__ int lds_byte(int r, int c) { const int st = (r >> 4) * 2 + (c >> 5), rr = r & 15, cc = c & 31, ob = rr * 64 + cc * 2; return st * 1024 + (ob ^ (((ob >> 9) & 1) << 5)); }
__host__ __device__ __forceinline__ void stage_rc(int b, int& R, int& C) { const int st = b / 1024, sb = b % 1024, swz = sb ^ (((sb >> 9) & 1) << 5); R = (st >> 1) * 16 + swz / 64; C = (st & 1) * 32 + (swz % 64) / 2; }
__host__ __device__ __forceinline__ int perm32(int rho) { const int n = rho >> 4, i = rho & 15; return 8 * (i >> 2) + 4 * n + (i & 3); }

struct Unit { int pm, pn; };
struct Gemm { const bf16_t* A; const bf16_t* Bt; int M, N, K; };

struct StaticOrder {
    int nM, nN, nwg, G, c, wgm;
    __host__ __device__ void init(int M, int N, int G_, int c_, int wgm_ = WGM) { nM = M / BM; nN = N / BM; nwg = nM * nN; G = G_; c = c_; wgm = wgm_; }
    __host__ __device__ bool next(int i, Unit& u) const {
        const long L = (long)i * G + c; if (L >= nwg) return false;
        int wgid = (int)L; { const int q = nwg / NXCD, r = nwg % NXCD, xcd = wgid % NXCD, off = wgid / NXCD; wgid = (xcd < r ? xcd * (q + 1) : r * (q + 1) + (xcd - r) * q) + off; }
        const int nig = wgm * nN, gid = wgid / nig, fm = gid * wgm, gsz = (nM - fm) < wgm ? (nM - fm) : wgm;
        u.pm = fm + ((wgid % nig) % gsz); u.pn = (wgid % nig) / gsz; return true;
    }
    __device__ __forceinline__ void a_ready(const Unit&) const {}
    __device__ __forceinline__ void done(const Unit&) const {}
};
__device__ __forceinline__ unsigned cvt_pk_bf16(float lo, float hi) { unsigned r; asm volatile("v_cvt_pk_bf16_f32 %0, %1, %2" : "=v"(r) : "v"(lo), "v"(hi)); return r; }
template <class Epi, class Sched, bool ALIGN_EPI = false, bool SP2 = false>
__device__ __forceinline__ void gemm_phase(PG8_LAS unsigned char* lds, const Gemm g, const Sched& S, const Epi& E) {
    int tid_ = threadIdx.x; asm volatile("" : "+v"(tid_)); const int tid = tid_, wid = __builtin_amdgcn_readfirstlane(tid >> 6), lane = tid & 63, wr = wid >> 2, wc = wid & 3, fr = lane & 15, fq = lane >> 4;
    const int K = g.K, nt = K / BK;
    unsigned voffA[2], voffB[2];
#pragma unroll
    for (int i = 0; i < 2; ++i) { int R, C; stage_rc(tid * 16 + i * 8192, R, C); const int Rb = Epi::PERM ? ((R & ~31) + perm32(R & 31)) : R;
        voffA[i] = (unsigned)(R * K + C) * 2u; voffB[i] = (unsigned)(Rb * K + C) * 2u; }
    const size_t kstep = (size_t)(BK * 2);
    const size_t hstep = (size_t)HALF * K * 2;
    const size_t tstep = 2 * hstep;
    const unsigned ldsw = (unsigned)wid * 1024u;
    const int aoff = lds_byte(wr * 64 + fr, fq * 8), boff = lds_byte(wc * 32 + fr, fq * 8);
#define PG8_SA(b, h) (((b) * 2 + (h)) * HTB)
#define PG8_SB(b, h) ((4 + (b) * 2 + (h)) * HTB)
#define PG8_STAGE(bufoff, gbase, voff) do { _Pragma("unroll") for (int _i = 0; _i < 2; ++_i) \
        __builtin_amdgcn_global_load_lds((const unsigned*)((const char*)(gbase) + (voff)[_i]), (PG8_LAS unsigned*)(lds + (bufoff) + ldsw + _i * 8192), 16, 0, 0); } while (0)
#define PG8_LDA(dst, b, h) do { _Pragma("unroll") for (int m = 0; m < 4; ++m) _Pragma("unroll") for (int k = 0; k < 2; ++k) dst[m][k] = *(const PG8_LAS bf16x8*)(lds + PG8_SA(b, h) + aoff + m * 2048 + k * 1024); } while (0)
#define PG8_LDB(dst, b, h) do { _Pragma("unroll") for (int n = 0; n < 2; ++n) _Pragma("unroll") for (int k = 0; k < 2; ++k) dst[n][k] = *(const PG8_LAS bf16x8*)(lds + PG8_SB(b, h) + boff + n * 2048 + k * 1024); } while (0)
#define PG8_MMA(ai, bj, At, Bt) do { __builtin_amdgcn_s_setprio(1); _Pragma("unroll") for (int m = 0; m < 4; ++m) _Pragma("unroll") for (int n = 0; n < 2; ++n) _Pragma("unroll") for (int k = 0; k < 2; ++k) \
        acc[ai][bj][m][n] = __builtin_amdgcn_mfma_f32_16x16x32_bf16(Bt[n][k], At[m][k], acc[ai][bj][m][n], 0, 0, 0); __builtin_amdgcn_s_setprio(0); } while (0)
#define PG8_WAIT_V(n) asm volatile("s_waitcnt vmcnt(" #n ")" ::: "memory")
#define PG8_WAIT_L(n) asm volatile("s_waitcnt lgkmcnt(" #n ")" ::: "memory")
#define PG8_BAR __builtin_amdgcn_s_barrier()
#define PG8_SCHED __builtin_amdgcn_sched_barrier(0)
    Unit cur, nxt; int ui = 0;
    if (!S.next(0, cur)) return;
    f32x4 acc[2][2][4][2];
#pragma unroll
    for (int a = 0; a < 2; ++a)
#pragma unroll
        for (int b = 0; b < 2; ++b)
#pragma unroll
            for (int m = 0; m < 4; ++m)
#pragma unroll
                for (int n = 0; n < 2; ++n) acc[a][b][m][n] = (f32x4){0.f, 0.f, 0.f, 0.f};
    bf16x8 At[4][2], B0[2][2], B1[2][2];
    const char* cA = (const char*)g.A + (size_t)cur.pm * tstep; const char* cB = (const char*)g.Bt + (size_t)cur.pn * tstep;
    S.a_ready(cur);
    if constexpr (SP2) {
        PG8_STAGE(PG8_SB(0, 0), cB, voffB); PG8_STAGE(PG8_SB(0, 1), cB + hstep, voffB); PG8_STAGE(PG8_SA(0, 0), cA, voffA); PG8_STAGE(PG8_SA(0, 1), cA + hstep, voffA);
        if (wr == 1) PG8_BAR;
        PG8_WAIT_V(2); PG8_BAR;
        PG8_STAGE(PG8_SB(1, 0), cB + kstep, voffB); PG8_STAGE(PG8_SA(1, 0), cA + kstep, voffA); PG8_STAGE(PG8_SB(1, 1), cB + hstep + kstep, voffB);
        PG8_WAIT_V(6); PG8_BAR;
    } else {
        PG8_STAGE(PG8_SB(0, 0), cB, voffB); PG8_STAGE(PG8_SA(0, 0), cA, voffA); PG8_STAGE(PG8_SB(0, 1), cB + hstep, voffB); PG8_STAGE(PG8_SA(0, 1), cA + hstep, voffA);
        if (wr == 1) PG8_BAR;
        PG8_WAIT_V(4); PG8_BAR;
        PG8_STAGE(PG8_SB(1, 0), cB + kstep, voffB); PG8_STAGE(PG8_SA(1, 0), cA + kstep, voffA); PG8_STAGE(PG8_SB(1, 1), cB + hstep + kstep, voffB);
        PG8_WAIT_V(6); PG8_BAR;
    }
    for (;;) {
        const bool has_next = S.next(ui + 1, nxt);
        const char* nA = has_next ? (const char*)g.A + (size_t)nxt.pm * tstep : cA; const char* nB = has_next ? (const char*)g.Bt + (size_t)nxt.pn * tstep : cB;
        for (int t = 0; t < nt; t += 2) {
            const bool last = (t == nt - 2);
            const char* a1 = cA + (size_t)(t + 1) * kstep;
            const char* a2 = last ? nA : cA + (size_t)(t + 2) * kstep; const char* b2 = last ? nB : cB + (size_t)(t + 2) * kstep;
            const char* a3 = a2 + kstep; const char* b3 = b2 + kstep;
            if (last && has_next) S.a_ready(nxt);
            if constexpr (SP2) {
            PG8_LDB(B0, 0, 0); PG8_LDB(B1, 0, 1); PG8_SCHED; PG8_LDA(At, 0, 0); PG8_STAGE(PG8_SA(1, 1), a1 + hstep, voffA);
            PG8_WAIT_V(8); PG8_WAIT_L(0); PG8_BAR; PG8_MMA(0, 0, At, B0); PG8_MMA(0, 1, At, B1); PG8_BAR; PG8_SCHED;
            PG8_LDA(At, 0, 1); PG8_STAGE(PG8_SB(0, 0), b2, voffB); PG8_STAGE(PG8_SB(0, 1), b2 + hstep, voffB); PG8_STAGE(PG8_SA(0, 0), a2, voffA);
            PG8_WAIT_V(8); PG8_WAIT_L(0); PG8_BAR; PG8_MMA(1, 0, At, B0); PG8_MMA(1, 1, At, B1); PG8_BAR; PG8_SCHED;
            PG8_LDB(B0, 1, 0); PG8_LDB(B1, 1, 1); PG8_SCHED; PG8_LDA(At, 1, 0); PG8_STAGE(PG8_SA(0, 1), a2 + hstep, voffA);
            PG8_WAIT_V(8); PG8_WAIT_L(0); PG8_BAR; PG8_MMA(0, 0, At, B0); PG8_MMA(0, 1, At, B1); PG8_BAR; PG8_SCHED;
            PG8_LDA(At, 1, 1); PG8_STAGE(PG8_SB(1, 0), b3, voffB); PG8_STAGE(PG8_SB(1, 1), b3 + hstep, voffB); PG8_STAGE(PG8_SA(1, 0), a3, voffA);
            PG8_WAIT_V(8); PG8_WAIT_L(0); PG8_BAR; PG8_MMA(1, 0, At, B0); PG8_MMA(1, 1, At, B1); PG8_BAR; PG8_SCHED;
            } else {
            PG8_LDB(B0, 0, 0); PG8_SCHED; PG8_LDA(At, 0, 0); PG8_STAGE(PG8_SA(1, 1), a1 + hstep, voffA);
            PG8_WAIT_L(8); PG8_BAR; PG8_WAIT_L(0); PG8_MMA(0, 0, At, B0); PG8_BAR; PG8_SCHED;
            PG8_LDB(B1, 0, 1); PG8_STAGE(PG8_SB(0, 0), b2, voffB);
            PG8_BAR; PG8_WAIT_L(0); PG8_MMA(0, 1, At, B1); PG8_BAR;
            PG8_LDA(At, 0, 1); PG8_STAGE(PG8_SA(0, 0), a2, voffA);
            PG8_BAR; PG8_WAIT_L(0); PG8_MMA(1, 0, At, B0); PG8_BAR; PG8_SCHED;
            PG8_STAGE(PG8_SB(0, 1), b2 + hstep, voffB);
            PG8_WAIT_V(6); PG8_BAR; PG8_MMA(1, 1, At, B1); PG8_BAR;
            PG8_LDB(B0, 1, 0); PG8_SCHED; PG8_LDA(At, 1, 0); PG8_STAGE(PG8_SA(0, 1), a2 + hstep, voffA);
            PG8_WAIT_L(8); PG8_BAR; PG8_WAIT_L(0); PG8_MMA(0, 0, At, B0); PG8_BAR; PG8_SCHED;
            PG8_LDB(B1, 1, 1); PG8_STAGE(PG8_SB(1, 0), b3, voffB);
            PG8_BAR; PG8_WAIT_L(0); PG8_MMA(0, 1, At, B1); PG8_BAR;
            PG8_LDA(At, 1, 1); PG8_STAGE(PG8_SA(1, 0), a3, voffA);
            PG8_BAR; PG8_WAIT_L(0); PG8_MMA(1, 0, At, B0); PG8_BAR; PG8_SCHED;
            PG8_STAGE(PG8_SB(1, 1), b3 + hstep, voffB);
            PG8_WAIT_V(6); PG8_BAR; PG8_MMA(1, 1, At, B1); PG8_BAR;
            }
        }
        if constexpr (ALIGN_EPI) { if (wr == 0) PG8_BAR; }
        if constexpr (!Epi::AFTER_DRAIN) { E(acc, cur, wr, wc, fr, fq); S.done(cur); }
        if (!has_next) break;
#pragma unroll
        for (int a = 0; a < 2; ++a)
#pragma unroll
            for (int b = 0; b < 2; ++b)
#pragma unroll
                for (int m = 0; m < 4; ++m)
#pragma unroll
                    for (int n = 0; n < 2; ++n) acc[a][b][m][n] = (f32x4){0.f, 0.f, 0.f, 0.f};
        cur = nxt; cA = nA; cB = nB; ++ui;
        if constexpr (ALIGN_EPI) { if (wr == 1) PG8_BAR; }
    }
    PG8_WAIT_V(0);
    if constexpr (!ALIGN_EPI) { if (wr == 0) PG8_BAR; }
    PG8_BAR;
    if constexpr (Epi::AFTER_DRAIN) { E.fused(acc, cur, wr, wc, fr, fq, lds, wid, lane); S.done(cur); }
#undef PG8_SA
#undef PG8_SB
#undef PG8_STAGE
#undef PG8_LDA
#undef PG8_LDB
#undef PG8_MMA
#undef PG8_WAIT_V
#undef PG8_WAIT_L
#undef PG8_BAR
#undef PG8_SCHED
}
}

#define XB_TMO      128
#define XB_XCNT(j)  (256  + 64 * (j))
#define XB_XSUB(j)  (1280 + 64 * (j))
#define XB_XGEN(j)  (2304 + 64 * (j))
#define XB_TOP      3328
#define XB_TOPGEN   3392
#define XCD_BAR_WORDS 3456
#define XB_SPIN_CAP (1u << 18)
#define LAS __attribute__((address_space(3)))

__device__ __forceinline__ unsigned xb_ld(unsigned* p)              { return __hip_atomic_load(p, __ATOMIC_RELAXED, __HIP_MEMORY_SCOPE_AGENT); }
__device__ __forceinline__ unsigned xb_add(unsigned* p, unsigned v) { return __hip_atomic_fetch_add(p, v, __ATOMIC_RELAXED, __HIP_MEMORY_SCOPE_AGENT); }
__device__ __forceinline__ unsigned xb_xcc_id() { return (unsigned)__builtin_amdgcn_s_getreg((3 << 11) | 20) & 0xFu; }
#define XB_SPIN(cond, bar) do { unsigned _sp = 0; while (cond) { __builtin_amdgcn_s_sleep(1); \
    if ((++_sp & 255u) == 0u) { if (xb_ld(&(bar)[XB_TMO])) break; if (_sp > XB_SPIN_CAP) { atomicAdd(&(bar)[XB_TMO], 1u); break; } } } } while (0)

struct XcdBarrier {
    unsigned* bar; unsigned x;
    volatile LAS unsigned* st;
};

__device__ __forceinline__ XcdBarrier xcd_barrier_post(unsigned* bar, volatile LAS unsigned* st) {
    XcdBarrier b; b.bar = bar; b.x = xb_xcc_id(); b.st = st;
    if (threadIdx.x == 0) (void)xb_add(&bar[XB_XCNT(b.x)], 1u);
    return b;
}
__device__ __forceinline__ void xcd_barrier_complete(unsigned* bar, unsigned x, unsigned& nloc, unsigned& nx) {
    const unsigned G = gridDim.x * gridDim.y * gridDim.z;
    unsigned sum, cnt, mine, sp = 0u;
    for (;;) {
        sum = 0u; cnt = 0u; mine = 0u;
#pragma unroll
        for (unsigned j = 0; j < 16; ++j) { const unsigned c = xb_ld(&bar[XB_XCNT(j)]); sum += c; cnt += (c > 0u) ? 1u : 0u; mine = (j == x) ? c : mine; }
        if (sum == G) break;
        __builtin_amdgcn_s_sleep(1);
        if ((++sp & 255u) == 0u) { if (xb_ld(&bar[XB_TMO])) break; if (sp > XB_SPIN_CAP) { atomicAdd(&bar[XB_TMO], 1u); break; } }
    }
    nloc = mine > 0u ? mine : 1u; nx = cnt > 0u ? cnt : 1u;
}

__device__ __forceinline__ void xcd_barrier(const XcdBarrier& b) {
    asm volatile("s_waitcnt vmcnt(0)" ::: "memory");
    __syncthreads();
    if (threadIdx.x == 0) {
        unsigned* bar = b.bar; unsigned bx = b.x; asm volatile("" : "+s"(bx));
        __builtin_amdgcn_s_waitcnt(0);
        unsigned nloc = b.st[0], nx = b.st[1];
        if (nloc == 0u) { xcd_barrier_complete(bar, bx, nloc, nx); b.st[0] = nloc; b.st[1] = nx; }
        const unsigned old = xb_add(&bar[XB_XSUB(bx)], 1u);
        const unsigned gen = old / nloc;
        if (old + 1u == (gen + 1u) * nloc) {
            __builtin_amdgcn_fence(__ATOMIC_RELEASE, "agent");
            asm volatile("s_waitcnt vmcnt(0)" ::: "memory");
            const unsigned og = xb_add(&bar[XB_TOP], 1u);
            const unsigned tg = og / nx;
            if (og + 1u == (tg + 1u) * nx) xb_add(&bar[XB_TOPGEN], 1u);
            else XB_SPIN(xb_ld(&bar[XB_TOPGEN]) == tg, bar);
            __builtin_amdgcn_fence(__ATOMIC_ACQUIRE, "agent");
            xb_add(&bar[XB_XGEN(bx)], 1u);
            asm volatile("s_waitcnt vmcnt(0)" ::: "memory");
        } else {
            XB_SPIN(xb_ld(&bar[XB_XGEN(bx)]) == gen, bar);
            __builtin_amdgcn_fence(__ATOMIC_ACQUIRE, "agent");
            asm volatile("s_waitcnt vmcnt(0)" ::: "memory");
        }
    }
    __syncthreads();
}
#ifndef GEMM_SP2
#define GEMM_SP2 true
#endif
#ifndef GEMM_ALIGN
#define GEMM_ALIGN true
#endif
namespace mk {
using pg8::bf16_t; using pg8::bf16x8; using pg8::f32x4;
typedef short s16x4 __attribute__((ext_vector_type(4)));
typedef unsigned u32x4 __attribute__((ext_vector_type(4)));
typedef unsigned u32x2 __attribute__((ext_vector_type(2)));
#define LDSP __attribute__((address_space(3)))
#define DI __device__ __forceinline__
DI int otid() { int t = threadIdx.x; asm volatile("" : "+v"(t)); return t; }
DI int obid() { int t = blockIdx.x; asm volatile("" : "+s"(t)); return t; }

constexpr int NB = 8, SEQ = 4096, DM = 1024, NTOK = NB * SEQ, NP = 3584, NIN = 3600;
constexpr int C_QA = 0, C_KA = 256, C_VA = 512, C_ZA = 1024, C_QB = 1536, C_KB = 2048, C_VB = 2560, C_ZB = 3072;
constexpr float EPS = 1e-6f;
constexpr int ATT_RS = 272;
constexpr int LDS_BAR_OFF = 131072;
constexpr int LDS_BYTES = LDS_BAR_OFF + 64;

struct Params {
    const float *x, *c, *w_ada, *b_ada, *g_pre, *w_in, *w_gu, *b_gu, *g_gla, *g_dil, *w_out, *g_post;
    float* out;
    unsigned* bar; float* mod; float2* rope; bf16_t* winT; bf16_t* woutT; bf16_t* hy; bf16_t* proj; bf16_t* yout;
    bf16_t* attO; float* attL; bf16_t* gst; float* gdec; bf16_t* wlrT; bf16_t* lab;
};

DI float bf2f(unsigned short b) { return __uint_as_float(((unsigned)b) << 16); }
typedef __bf16 hbf2 __attribute__((ext_vector_type(2)));
typedef float hf2 __attribute__((ext_vector_type(2)));
DI unsigned pk2(float lo, float hi) { hf2 v = {lo, hi}; return __builtin_bit_cast(unsigned, __builtin_convertvector(v, hbf2)); }
DI unsigned short f2bf(float f) { return (unsigned short)(pk2(f, 0.f) & 0xFFFFu); }
DI float silu(float v) { return v / (1.0f + __expf(-v)); }
DI f32x4 mfma16(bf16x8 a, bf16x8 b, f32x4 c) { return __builtin_amdgcn_mfma_f32_16x16x32_bf16(a, b, c, 0, 0, 0); }
DI s16x4 tr4(LDSP unsigned char* base, int row, int rs, int colbyte) {
    return __builtin_amdgcn_ds_read_tr16_b64_v4i16((LDSP s16x4*)(base + row * rs + colbyte));
}
DI bf16x8 cat8(s16x4 a, s16x4 b) { return __builtin_shufflevector(a, b, 0, 1, 2, 3, 4, 5, 6, 7); }
DI bf16x8 pack8(f32x4 a, f32x4 b) {
    typedef unsigned u32x4 __attribute__((ext_vector_type(4)));
    u32x4 r; r[0] = pk2(a[0], a[1]); r[1] = pk2(a[2], a[3]); r[2] = pk2(b[0], b[1]); r[3] = pk2(b[2], b[3]);
    return __builtin_bit_cast(bf16x8, r);
}

struct EpiProj {
    static constexpr bool PERM = true, AFTER_DRAIN = false;
    bf16_t* O; const float2* rope;
    DI void store8(bf16_t* p, f32x4 v0, f32x4 v1) const {
        uint4 o; o.x = pk2(v0[0], v0[1]); o.y = pk2(v0[2], v0[3]); o.z = pk2(v1[0], v1[1]); o.w = pk2(v1[2], v1[3]);
        *(uint4*)p = o;
    }
    DI void operator()(const f32x4 (&acc)[2][2][4][2], const pg8::Unit& u, int wr, int wc, int fr, int fq) const {
        const int row0 = u.pm * 256 + wr * 64 + fr, col0 = u.pn * 256 + wc * 32 + 8 * fq;
        if (u.pn >= 6 && u.pn <= 9) {
            const int j0 = 16 * wc + 4 * fq;
#pragma unroll
            for (int ai = 0; ai < 2; ++ai)
#pragma unroll
                for (int m = 0; m < 4; ++m) {
                    const int row = row0 + ai * 128 + m * 16, pos = row & (SEQ - 1);
                    const f32x4 t0 = *(const f32x4*)(rope + pos * 64 + j0), t1 = *(const f32x4*)(rope + pos * 64 + j0 + 2);
                    bf16_t* rowp = O + (size_t)row * NP + col0;
#pragma unroll
                    for (int bj = 0; bj < 2; ++bj) {
                        const f32x4 a0 = acc[ai][bj][m][0], a1 = acc[ai][bj][m][1]; f32x4 v0, v1;
                        v0[0] = a0[0] * t0[0] - a0[1] * t0[1]; v0[1] = a0[1] * t0[0] + a0[0] * t0[1];
                        v0[2] = a0[2] * t0[2] - a0[3] * t0[3]; v0[3] = a0[3] * t0[2] + a0[2] * t0[3];
                        v1[0] = a1[0] * t1[0] - a1[1] * t1[1]; v1[1] = a1[1] * t1[0] + a1[0] * t1[1];
                        v1[2] = a1[2] * t1[2] - a1[3] * t1[3]; v1[3] = a1[3] * t1[2] + a1[2] * t1[3];
                        store8(rowp + bj * 128, v0, v1);
                    }
                }
        } else {
#pragma unroll
            for (int ai = 0; ai < 2; ++ai)
#pragma unroll
                for (int m = 0; m < 4; ++m) {
                    bf16_t* rowp = O + (size_t)(row0 + ai * 128 + m * 16) * NP + col0;
#pragma unroll
                    for (int bj = 0; bj < 2; ++bj) store8(rowp + bj * 128, acc[ai][bj][m][0], acc[ai][bj][m][1]);
                }
        }
    }
};
struct EpiOut {
    static constexpr bool PERM = true, AFTER_DRAIN = false;
    bf16_t* C; int ldc;
    DI void operator()(const f32x4 (&acc)[2][2][4][2], const pg8::Unit& u, int wr, int wc, int fr, int fq) const {
        const int row0 = u.pm * 256 + wr * 64 + fr, col0 = u.pn * 256 + wc * 32 + 8 * fq;
#pragma unroll
        for (int ai = 0; ai < 2; ++ai)
#pragma unroll
            for (int m = 0; m < 4; ++m) { bf16_t* rowp = C + (size_t)(row0 + ai * 128 + m * 16) * ldc + col0;
#pragma unroll
                for (int bj = 0; bj < 2; ++bj) { const f32x4 v0 = acc[ai][bj][m][0], v1 = acc[ai][bj][m][1];
                    u32x4 o; o[0] = pk2(v0[0], v0[1]); o[1] = pk2(v0[2], v0[3]); o[2] = pk2(v1[0], v1[1]); o[3] = pk2(v1[2], v1[3]);
                    *(u32x4*)(rowp + bj * 128) = o; } }
    }
};

DI void rope_entry(int pos, int j, float& co, float& si) {
    const double invd = exp2(-(double)(2 * j) * (13.287712379549449 / 128.0));
    const float invf = (float)invd, angf = (float)pos * invf;
    const double a = (double)angf, k = rint(a * 0.6366197723675814);
    double y = fma(-k, 1.5707963267948966, a); y = fma(-k, 6.123233995736766e-17, y);
    const int q = ((int)k) & 3; const double y2 = y * y;
    double sp = -2.5052108385441720e-08; sp = sp * y2 + 2.7557319223985893e-06; sp = sp * y2 - 1.9841269841269841e-04; sp = sp * y2 + 8.3333333333333332e-03; sp = sp * y2 - 1.6666666666666666e-01; sp = y + y * y2 * sp;
    double cp = 2.0876756987868100e-09; cp = cp * y2 - 2.7557319223985888e-07; cp = cp * y2 + 2.4801587301587302e-05; cp = cp * y2 - 1.3888888888888889e-03; cp = cp * y2 + 4.1666666666666664e-02; cp = cp * y2 - 0.5; cp = 1.0 + y2 * cp;
    const double s = (q == 0) ? sp : (q == 1) ? cp : (q == 2) ? -sp : -cp;
    const double c = (q == 0) ? cp : (q == 1) ? -sp : (q == 2) ? -cp : sp;
    co = (float)c; si = (float)s;
}

DI void phase0(const Params& p, LDSP unsigned char* lds) {
    const int tid = otid(), G = gridDim.x, bid = obid();
    if (bid < 192) {
        LDSP float* sc = (LDSP float*)lds;
        LDSP float* red = (LDSP float*)(lds + 32768);
        for (int i = tid; i < 8 * 1024; i += 512) sc[i] = silu(p.c[i]);
        __syncthreads();
        for (int item = bid; item < 192; item += G) {
            const int l = item / 96, cg = item % 96, col = cg * 32 + (tid & 31), kg = tid >> 5;
            const float* wp = p.w_ada + ((size_t)l * 1024 + kg * 64) * 3072 + col;
            float a[8] = {0.f, 0.f, 0.f, 0.f, 0.f, 0.f, 0.f, 0.f};
#pragma unroll
            for (int k0 = 0; k0 < 64; k0 += 32) { float wv[32];
#pragma unroll
                for (int k = 0; k < 32; ++k) wv[k] = wp[(size_t)(k0 + k) * 3072];
#pragma unroll
                for (int k = 0; k < 32; ++k)
#pragma unroll
                    for (int b = 0; b < 8; ++b) a[b] += sc[b * 1024 + kg * 64 + k0 + k] * wv[k]; }
#pragma unroll
            for (int b = 0; b < 8; ++b) red[(kg * 8 + b) * 32 + (tid & 31)] = a[b];
            __syncthreads();
            if (tid < 256) { const int b = tid >> 5, cc = tid & 31; float s = 0.f;
                for (int q = 0; q < 16; ++q) s += red[(q * 8 + b) * 32 + cc];
                p.mod[((size_t)l * 8 + b) * 3072 + cg * 32 + cc] = s + p.b_ada[l * 3072 + cg * 32 + cc]; }
            __syncthreads();
        }
    }
    for (int e = bid * 512 + tid; e < SEQ * 64; e += G * 512) { float co, si; rope_entry(e >> 6, e & 63, co, si); p.rope[e] = make_float2(co, si); }
    for (int e = bid * 512 + tid; e < 2 * 16 * 1024; e += G * 512) { const int l = e >> 14, r = (e >> 10) & 15, k = e & 1023; p.wlrT[e] = f2bf(p.w_in[((size_t)l * 1024 + k) * NIN + 1536 + r]); }
}

DI void phase0c(const Params& p, LDSP unsigned char* lds) {
    const int tid = otid(), G = gridDim.x, bid = obid();
    LDSP float* tile = (LDSP float*)lds;
    const int NT_IN = 2 * 56 * 4, NT_OUT = 2 * 16 * 4;
    for (int item = bid; item < NT_IN + NT_OUT; item += G) {
        __syncthreads();
        const bool is_in = item < NT_IN;
        int l, nt, kq; if (is_in) { l = item / 224; const int r = item % 224; nt = r >> 2; kq = r & 3; } else { const int r2 = item - NT_IN; l = r2 >> 6; nt = (r2 >> 2) & 15; kq = r2 & 3; }
        const int nn = nt * 64 + (tid & 63);
        const float* src; size_t ld; float scale = 1.f;
        if (is_in) {
            int sc = 0;
            if (nn < C_QB) { sc = nn; scale = (nn < 256) ? 0.125f : 1.f; }
            else if (nn < C_VB) { const int o = nn - C_QB, grp = o >> 9, hh = (o >> 7) & 3, cp = o & 127; const int old = (cp & 1) ? 64 + (cp >> 1) : (cp >> 1);
                sc = 1552 + grp * 512 + hh * 128 + old; scale = grp == 0 ? 0.08838834764831845f : 1.f; }
            else { sc = nn + 16; }
            src = p.w_in + (size_t)l * 1024 * NIN + sc; ld = NIN;
        } else { src = p.w_out + (size_t)l * 1024 * 1024 + nn; ld = 1024; }
        src += (size_t)(kq * 256 + (tid >> 6)) * ld;
#pragma unroll
        for (int i0 = 0; i0 < 32; i0 += 8) { float v[8];
#pragma unroll
            for (int i = 0; i < 8; ++i) v[i] = src[(size_t)(8 * (i0 + i)) * ld];
#pragma unroll
            for (int i = 0; i < 8; ++i) tile[((tid >> 6) + 8 * (i0 + i)) * 65 + (tid & 63)] = v[i] * scale; }
        __syncthreads();
#pragma unroll
        for (int q = 0; q < 4; ++q) { const int ch = tid + 512 * q, n = ch >> 5, k8 = (ch & 31) * 8;
            u32x4 o; o[0] = pk2(tile[(k8 + 0) * 65 + n], tile[(k8 + 1) * 65 + n]); o[1] = pk2(tile[(k8 + 2) * 65 + n], tile[(k8 + 3) * 65 + n]);
            o[2] = pk2(tile[(k8 + 4) * 65 + n], tile[(k8 + 5) * 65 + n]); o[3] = pk2(tile[(k8 + 6) * 65 + n], tile[(k8 + 7) * 65 + n]);
            bf16_t* dst = is_in ? p.winT + ((size_t)l * NP + nt * 64 + n) * 1024 + kq * 256 + k8 : p.woutT + ((size_t)l * 1024 + nt * 64 + n) * 1024 + kq * 256 + k8;
            *(u32x4*)dst = o; }
    }
    __syncthreads();
}

DI void norm_pass(const Params& p, int mode) {
    const int tid = otid(), lane = tid & 63, w = tid >> 6, stride = gridDim.x * 8;
    const bf16_t* y0 = (const bf16_t*)p.out + 1024;
    for (int rowa = obid() * 8 + w; rowa < NTOK; rowa += 2 * stride) {
        int rows[2]; rows[0] = rowa; rows[1] = (rowa + stride < NTOK) ? rowa + stride : rowa;
        const bool dup = rows[1] == rows[0];
        f32x4 xv[2][4]; u32x4 yv[2][2], yw[2][2];
#pragma unroll
        for (int u = 0; u < 2; ++u) {
            const float* xin = p.x + (size_t)rows[u] * DM + 8 * lane;
#pragma unroll
            for (int q = 0; q < 2; ++q) { xv[u][2 * q] = *(const f32x4*)(xin + 512 * q); xv[u][2 * q + 1] = *(const f32x4*)(xin + 512 * q + 4); }
            if (mode != 0) {
#pragma unroll
                for (int q = 0; q < 2; ++q) yv[u][q] = *(const u32x4*)(y0 + (size_t)rows[u] * 2048 + 512 * q + 8 * lane); }
            if (mode == 2) {
#pragma unroll
                for (int q = 0; q < 2; ++q) yw[u][q] = *(const u32x4*)(p.yout + (size_t)rows[u] * DM + 512 * q + 8 * lane); }
        }
#pragma unroll
        for (int u = 0; u < 2; ++u) {
            const int row = rows[u], b = row >> 12;
#pragma unroll
            for (int lp = 0; lp < 2; ++lp) {
                if ((lp == 0 && mode != 0) || (lp == 1 && mode == 2)) {
                    float yf[16]; float ss = 0.f;
#pragma unroll
                    for (int q = 0; q < 2; ++q)
#pragma unroll
                        for (int e = 0; e < 4; ++e) { const unsigned uu = lp ? yw[u][q][e] : yv[u][q][e]; yf[8 * q + 2 * e] = __uint_as_float(uu << 16); yf[8 * q + 2 * e + 1] = __uint_as_float(uu & 0xFFFF0000u); }
#pragma unroll
                    for (int e = 0; e < 16; ++e) ss += yf[e] * yf[e];
#pragma unroll
                    for (int m = 1; m < 64; m <<= 1) ss += __shfl_xor(ss, m);
                    const float rs = rsqrtf(ss * (1.0f / DM) + EPS);
                    const float* gate = p.mod + ((size_t)lp * 8 + b) * 3072 + 2048 + 8 * lane; const float* gp = p.g_post + lp * DM + 8 * lane;
#pragma unroll
                    for (int q = 0; q < 4; ++q) { const int co = 512 * (q >> 1) + 4 * (q & 1); const f32x4 gt = *(const f32x4*)(gate + co), gg = *(const f32x4*)(gp + co);
#pragma unroll
                        for (int e = 0; e < 4; ++e) xv[u][q][e] += gt[e] * (yf[4 * q + e] * rs * gg[e]); }
                }
            }
            if (mode == 2) {
                if (!(u == 1 && dup)) {
#pragma unroll
                    for (int q = 0; q < 4; ++q) { const int co = 512 * (q >> 1) + 4 * (q & 1); *(f32x4*)(p.out + (size_t)row * DM + 8 * lane + co) = xv[u][q]; } }
            } else {
                const int lcur = mode;
                float ss = 0.f;
#pragma unroll
                for (int q = 0; q < 4; ++q)
#pragma unroll
                    for (int e = 0; e < 4; ++e) ss += xv[u][q][e] * xv[u][q][e];
#pragma unroll
                for (int m = 1; m < 64; m <<= 1) ss += __shfl_xor(ss, m);
                const float rs = rsqrtf(ss * (1.0f / DM) + EPS);
                const float* md = p.mod + ((size_t)lcur * 8 + b) * 3072 + 8 * lane; const float* gp = p.g_pre + lcur * DM + 8 * lane;
#pragma unroll
                for (int q = 0; q < 2; ++q) { float hv[8];
#pragma unroll
                    for (int hf = 0; hf < 2; ++hf) { const int co = 512 * q + 4 * hf;
                        const f32x4 sh = *(const f32x4*)(md + co), scl = *(const f32x4*)(md + 1024 + co), gg = *(const f32x4*)(gp + co);
#pragma unroll
                        for (int e = 0; e < 4; ++e) hv[4 * hf + e] = (xv[u][2 * q + hf][e] * rs * gg[e]) * (1.0f + scl[e]) + sh[e]; }
                    u32x4 o; o[0] = pk2(hv[0], hv[1]); o[1] = pk2(hv[2], hv[3]); o[2] = pk2(hv[4], hv[5]); o[3] = pk2(hv[6], hv[7]);
                    *(u32x4*)(p.hy + (size_t)row * DM + 512 * q + 8 * lane) = o; }
            }
        }
    }
}

DI void lr_phase(const Params& p, LDSP unsigned char* lds, int layer) {
    const int tid = otid(), w = tid >> 6, lane = tid & 63, c = lane & 15, g = lane >> 4, G = gridDim.x;
    LDSP float* lrs = (LDSP float*)lds;
    LDSP unsigned char* wlr = lds + 10240;
    for (int i = tid; i < 2048; i += 512) { const int r = i >> 7, ch = i & 127; *(LDSP u32x4*)(wlr + r * 2064 + ch * 16) = *(const u32x4*)(p.wlrT + (size_t)layer * 16384 + r * 1024 + ch * 8); }
    f32x4 wv[16];
#pragma unroll
    for (int r = 0; r < 16; ++r) wv[r] = *(const f32x4*)(p.w_gu + (size_t)layer * 4096 + r * 256 + 4 * lane);
    const f32x4 bias = *(const f32x4*)(p.b_gu + layer * 256 + 4 * lane);
    for (int slab = obid(); slab < NTOK / 128; slab += G) {
        const bf16_t* hp = p.hy + ((size_t)slab * 128 + 16 * w + c) * DM + 8 * g;
        bf16x8 a[32];
#pragma unroll
        for (int s = 0; s < 32; ++s) a[s] = *(const bf16x8*)(hp + 32 * s);
        __syncthreads();
        f32x4 acc0 = {0.f, 0.f, 0.f, 0.f}, acc1 = acc0;
#pragma unroll
        for (int s = 0; s < 32; s += 2) {
            acc0 = mfma16(a[s], *(const LDSP bf16x8*)(wlr + c * 2064 + (32 * s + 8 * g) * 2), acc0);
            acc1 = mfma16(a[s + 1], *(const LDSP bf16x8*)(wlr + c * 2064 + (32 * (s + 1) + 8 * g) * 2), acc1);
        }
#pragma unroll
        for (int e = 0; e < 4; ++e) lrs[(16 * w + 4 * g + e) * 20 + c] = acc0[e] + acc1[e];
        __syncthreads();
        bf16_t* op = p.lab + ((size_t)slab * 128 + 16 * w) * 256 + 4 * lane;
#pragma unroll 4
        for (int tk = 0; tk < 16; ++tk) {
            const LDSP float* lp = lrs + (16 * w + tk) * 20;
            const f32x4 l0 = *(const LDSP f32x4*)lp, l1 = *(const LDSP f32x4*)(lp + 4), l2 = *(const LDSP f32x4*)(lp + 8), l3 = *(const LDSP f32x4*)(lp + 12);
            f32x4 z = bias;
#pragma unroll
            for (int r = 0; r < 4; ++r) { z += wv[r] * l0[r]; z += wv[4 + r] * l1[r]; z += wv[8 + r] * l2[r]; z += wv[12 + r] * l3[r]; }
#pragma unroll
            for (int e = 0; e < 4; ++e) z[e] = (fminf(z[e], 0.f) - __logf(1.0f + __expf(-fabsf(z[e])))) * 0.0625f;
            u32x2 o; o[0] = pk2(z[0], z[1]); o[1] = pk2(z[2], z[3]);
            *(u32x2*)(op + (size_t)tk * 256) = o;
        }
    }
    __syncthreads();
}

struct A2Task { int b, head, pat, d, r, n2; };
DI A2Task a2_decode(int task) {
    A2Task t; const int bh = task / 48, sub = task % 48, s4 = sub & 15; t.b = bh >> 2; t.head = bh & 3; t.pat = sub >> 4;
    if (t.pat == 0) { t.d = 1; t.r = 0; t.n2 = s4; } else if (t.pat == 1) { t.d = 4; t.r = s4 & 3; t.n2 = s4 >> 2; } else { t.d = 16; t.r = s4; t.n2 = 0; }
    return t;
}
DI void a2_issue_rows(const Params& p, const A2Task& t, int tid_in, int coff, u32x4 (&R)[12]) {
    int tid = tid_in; asm volatile("" : "+v"(tid));
    const bf16_t* base = p.proj + (size_t)t.b * SEQ * NP + t.head * 128 + coff;
#pragma unroll
    for (int i = 0; i < 12; ++i) {
        const int ch = tid + 512 * i, row = ch >> 4, c16 = ch & 15, ci = 256 * t.n2 - 128 + row;
        u32x4 v = {0u, 0u, 0u, 0u};
        if (ci >= 0) v = *(const u32x4*)(base + (size_t)(ci * t.d + t.r) * NP + c16 * 8);
        R[i] = v;
    }
}
DI void a2_issue_q(const Params& p, const A2Task& t, int tid_in, bf16x8 (&Q)[2][4]) {
    int tid = tid_in; asm volatile("" : "+v"(tid));
    const int w = tid >> 6, lane = tid & 63, c = lane & 15, g = lane >> 4;
    const bf16_t* base = p.proj + (size_t)t.b * SEQ * NP + t.head * 128 + C_QB + 8 * g;
#pragma unroll
    for (int qt = 0; qt < 2; ++qt) { const int posq = (256 * t.n2 + 32 * w + 16 * qt + c) * t.d + t.r;
#pragma unroll
        for (int s = 0; s < 4; ++s) Q[qt][s] = *(const bf16x8*)(base + (size_t)posq * NP + 32 * s); }
}
DI void attn2_phase(const Params& p, LDSP unsigned char* lds) {
    const int tid = otid(), w = tid >> 6, lane = tid & 63, c = lane & 15, g = lane >> 4, G = gridDim.x;
    LDSP unsigned char* Ls = lds;
    const int bid0 = obid(), xcd = bid0 & 7, local = bid0 >> 3;
    const int nx = (G >= 8) ? 8 : G, per = (32 / nx) * 48, nwl = (G - xcd + 7) >> 3;
#define A2_TASK(i) ((xcd * (32 / nx) + (i) / 48) * 48 + (i) % 48)
    u32x4 kr[12], vr[12]; bf16x8 qn[2][4];
    int it = local;
    if (it < per) { const A2Task t0 = a2_decode(A2_TASK(it)); a2_issue_rows(p, t0, tid, C_KB, kr); a2_issue_q(p, t0, tid, qn); }
    for (; it < per; it += nwl) {
        const A2Task t = a2_decode(A2_TASK(it));
{ int t2 = tid; asm volatile("" : "+v"(t2)); LDSP unsigned char* wb = Ls + (t2 >> 4) * ATT_RS + (t2 & 15) * 16;
#pragma unroll
        for (int i = 0; i < 12; ++i) *(LDSP u32x4*)(wb + i * 32 * ATT_RS) = kr[i]; }
        bf16x8 qf[2][4];
#pragma unroll
        for (int qt = 0; qt < 2; ++qt)
#pragma unroll
            for (int s = 0; s < 4; ++s) qf[qt][s] = qn[qt][s];
        __syncthreads();
        a2_issue_rows(p, t, tid, C_VB, vr);
        f32x4 sA[9], sB[9];
        {
            const LDSP unsigned char* kbase = Ls + (32 * w + c) * ATT_RS + 16 * g;
#define A2_LDK(dst, kt) _Pragma("unroll") for (int s = 0; s < 4; ++s) dst[s] = *(const LDSP bf16x8*)(kbase + (kt) * 16 * ATT_RS + 64 * s)
#define A2_SB __builtin_amdgcn_sched_barrier(0)
#define A2_MM(K, kt) do { f32x4 x0 = {0.f, 0.f, 0.f, 0.f}, x1 = x0; \
            _Pragma("unroll") for (int s = 0; s < 4; ++s) { if ((kt) <= 8) x0 = mfma16(K[s], qf[0][s], x0); if ((kt) >= 1) x1 = mfma16(K[s], qf[1][s], x1); } \
            if ((kt) <= 8) sA[(kt) <= 8 ? (kt) : 0] = x0; if ((kt) >= 1) sB[(kt) >= 1 ? (kt) - 1 : 0] = x1; } while (0)
            bf16x8 ka[4], kb[4];
            A2_LDK(ka, 0); A2_SB;
            A2_LDK(kb, 1); A2_SB; A2_MM(ka, 0); A2_SB;
            A2_LDK(ka, 2); A2_SB; A2_MM(kb, 1); A2_SB;
            A2_LDK(kb, 3); A2_SB; A2_MM(ka, 2); A2_SB;
            A2_LDK(ka, 4); A2_SB; A2_MM(kb, 3); A2_SB;
            A2_LDK(kb, 5); A2_SB; A2_MM(ka, 4); A2_SB;
            A2_LDK(ka, 6); A2_SB; A2_MM(kb, 5); A2_SB;
            A2_LDK(kb, 7); A2_SB; A2_MM(ka, 6); A2_SB;
            A2_LDK(ka, 8); A2_SB; A2_MM(kb, 7); A2_SB;
            A2_LDK(kb, 9); A2_SB; A2_MM(ka, 8); A2_SB;
            A2_MM(kb, 9);
        }
#pragma unroll
        for (int e = 0; e < 4; ++e) { const bool lo = (4 * g + e >= c), hi = (4 * g + e <= c);
            sA[0][e] = lo ? sA[0][e] : -INFINITY; sA[8][e] = hi ? sA[8][e] : -INFINITY; sB[0][e] = lo ? sB[0][e] : -INFINITY; sB[8][e] = hi ? sB[8][e] : -INFINITY; }
        if (t.n2 == 0) {
#pragma unroll
            for (int j = 0; j < 9; ++j)
#pragma unroll
                for (int e = 0; e < 4; ++e) { sA[j][e] = (32 * w + 16 * j + 4 * g + e >= 128) ? sA[j][e] : -INFINITY; sB[j][e] = (32 * w + 16 * (j + 1) + 4 * g + e >= 128) ? sB[j][e] : -INFINITY; }
        }
        float mxA = -INFINITY, mxB = -INFINITY;
#pragma unroll
        for (int j = 0; j < 9; ++j)
#pragma unroll
            for (int e = 0; e < 4; ++e) { mxA = fmaxf(mxA, sA[j][e]); mxB = fmaxf(mxB, sB[j][e]); }
        mxA = fmaxf(mxA, __shfl_xor(mxA, 16)); mxA = fmaxf(mxA, __shfl_xor(mxA, 32)); mxB = fmaxf(mxB, __shfl_xor(mxB, 16)); mxB = fmaxf(mxB, __shfl_xor(mxB, 32));
        float lsA = 0.f, lsB = 0.f;
#pragma unroll
        for (int j = 0; j < 9; ++j)
#pragma unroll
            for (int e = 0; e < 4; ++e) { const float pa = __expf(sA[j][e] - mxA), pb = __expf(sB[j][e] - mxB); sA[j][e] = pa; sB[j][e] = pb; lsA += pa; lsB += pb; }
        lsA += __shfl_xor(lsA, 16); lsA += __shfl_xor(lsA, 32); lsB += __shfl_xor(lsB, 16); lsB += __shfl_xor(lsB, 32);
        bf16x8 pfA[5], pfB[5];
        { const f32x4 zero4 = {0.f, 0.f, 0.f, 0.f};
#pragma unroll
          for (int s = 0; s < 4; ++s) pfA[s] = pack8(sA[2 * s], sA[2 * s + 1]);
          pfA[4] = pack8(sA[8], zero4);
          pfB[0] = pack8(zero4, sB[0]);
#pragma unroll
          for (int s = 1; s < 5; ++s) pfB[s] = pack8(sB[2 * s - 1], sB[2 * s]); }
        __syncthreads();
{ int t2 = tid; asm volatile("" : "+v"(t2)); LDSP unsigned char* wb = Ls + (t2 >> 4) * ATT_RS + (t2 & 15) * 16;
#pragma unroll
        for (int i = 0; i < 12; ++i) *(LDSP u32x4*)(wb + i * 32 * ATT_RS) = vr[i]; }
        __syncthreads();
        if (it + nwl < per) { const A2Task tn = a2_decode(A2_TASK(it + nwl)); a2_issue_rows(p, tn, tid, C_KB, kr); a2_issue_q(p, tn, tid, qn); }
        f32x4 oA[8], oB[8];
#pragma unroll
        for (int dt = 0; dt < 8; ++dt) { oA[dt] = (f32x4){0.f, 0.f, 0.f, 0.f}; oB[dt] = oA[dt]; }
        {
            const int q4 = c >> 2, p4 = c & 3, rb = 32 * w + 4 * g + q4;
#define A2_LDV(dst, bt) do { const int r0_ = rb + 32 * ((bt) >> 1), r1_ = r0_ + 16; \
            _Pragma("unroll") for (int d = 0; d < 4; ++d) { const int cb_ = (16 * (4 * ((bt) & 1) + d) + 4 * p4) * 2; dst[d] = cat8(tr4(Ls, r0_, ATT_RS, cb_), tr4(Ls, r1_, ATT_RS, cb_)); } } while (0)
#define A2_MMV(src, bt) _Pragma("unroll") for (int d = 0; d < 4; ++d) { oA[4 * ((bt) & 1) + d] = mfma16(src[d], pfA[(bt) >> 1], oA[4 * ((bt) & 1) + d]); oB[4 * ((bt) & 1) + d] = mfma16(src[d], pfB[(bt) >> 1], oB[4 * ((bt) & 1) + d]); }
            bf16x8 va[4], vb[4];
            A2_LDV(va, 0); A2_SB;
            A2_LDV(vb, 1); A2_SB; A2_MMV(va, 0); A2_SB;
            A2_LDV(va, 2); A2_SB; A2_MMV(vb, 1); A2_SB;
            A2_LDV(vb, 3); A2_SB; A2_MMV(va, 2); A2_SB;
            A2_LDV(va, 4); A2_SB; A2_MMV(vb, 3); A2_SB;
            A2_LDV(vb, 5); A2_SB; A2_MMV(va, 4); A2_SB;
            A2_LDV(va, 6); A2_SB; A2_MMV(vb, 5); A2_SB;
            A2_LDV(vb, 7); A2_SB; A2_MMV(va, 6); A2_SB;
            A2_LDV(va, 8); A2_SB; A2_MMV(vb, 7); A2_SB;
            A2_LDV(vb, 9); A2_SB; A2_MMV(va, 8); A2_SB;
            A2_MMV(vb, 9);
        }
        __syncthreads();
        {
            const float invA = 1.0f / lsA, invB = 1.0f / lsB;
            LDSP unsigned char* st = Ls + w * (32 * ATT_RS);
#pragma unroll
            for (int dt = 0; dt < 8; ++dt) { u32x2 o; o[0] = pk2(oA[dt][0] * invA, oA[dt][1] * invA); o[1] = pk2(oA[dt][2] * invA, oA[dt][3] * invA); *(LDSP u32x2*)(st + c * ATT_RS + (16 * dt + 4 * g) * 2) = o;
                u32x2 o2; o2[0] = pk2(oB[dt][0] * invB, oB[dt][1] * invB); o2[1] = pk2(oB[dt][2] * invB, oB[dt][3] * invB); *(LDSP u32x2*)(st + (16 + c) * ATT_RS + (16 * dt + 4 * g) * 2) = o2; }
            const size_t tokbase = (size_t)t.pat * NTOK + (size_t)t.b * SEQ;
#pragma unroll 2
            for (int k = 0; k < 8; ++k) { const int id = lane + 64 * k, row = id >> 4, c16 = id & 15;
                const u32x4 v = *(const LDSP u32x4*)(st + row * ATT_RS + c16 * 16);
                const int pos = (256 * t.n2 + 32 * w + row) * t.d + t.r;
                *(u32x4*)(p.attO + (tokbase + pos) * 512 + t.head * 128 + c16 * 8) = v; }
            if (g == 0) { const int posA = (256 * t.n2 + 32 * w + c) * t.d + t.r, posB = posA + 16 * t.d;
                p.attL[(tokbase + posA) * 4 + t.head] = mxA + __logf(lsA); p.attL[(tokbase + posB) * 4 + t.head] = mxB + __logf(lsB); }
        }
        __syncthreads();
    }
}

DI void gla_cumsum(const float (&la)[8], LDSP float* segs, int dk, int seg, float (&bcum)[8], float& total) {
    float run = 0.f;
#pragma unroll
    for (int jj = 0; jj < 8; ++jj) { run += la[jj]; bcum[jj] = run; }
    segs[seg * 64 + dk] = run;
    __syncthreads();
    float pre = 0.f, tot = 0.f;
#pragma unroll
    for (int s = 0; s < 8; ++s) { const float v = segs[s * 64 + dk]; tot += v; pre += (s < seg) ? v : 0.f; }
#pragma unroll
    for (int jj = 0; jj < 8; ++jj) bcum[jj] += pre;
    total = tot;
}

constexpr int GL_LA = 0, GL_KK = 9216, GL_QQ = 18432, GL_VG = 27648, GL_BF = 45056, GL_ZT = 62464, GL_SEG = 79872, GL_SSQ = 81920, GL_OST = 82432;
struct CsPre { u32x4 la, k, v[2]; };
DI void cs_issue(const Params& p, int task, int tid, CsPre& R) {
    const int bh = task >> 6, n = task & 63, b = bh >> 2, h = bh & 3;
    const bf16_t* rp = p.proj + ((size_t)b * SEQ + n * 64) * NP;
    { const bf16_t* q = rp + (size_t)(tid >> 3) * NP + h * 64 + (tid & 7) * 8; R.la = *(const u32x4*)(p.lab + ((size_t)b * SEQ + n * 64 + (tid >> 3)) * 256 + h * 64 + (tid & 7) * 8); R.k = *(const u32x4*)(q + C_KA); }
#pragma unroll
    for (int i = 0; i < 2; ++i) { const int ch = tid + 512 * i; R.v[i] = *(const u32x4*)(rp + (size_t)(ch >> 4) * NP + C_VA + h * 128 + (ch & 15) * 8); }
}
DI void gla_cs_phase(const Params& p, LDSP unsigned char* lds) {
    const int tid = otid(), w = tid >> 6, lane = tid & 63, c = lane & 15, g = lane >> 4, dk = tid & 63, seg = tid >> 6, G = gridDim.x;
    LDSP unsigned char* LA = lds + GL_LA; LDSP unsigned char* KK = lds + GL_KK; LDSP unsigned char* KeT = lds + GL_QQ; LDSP unsigned char* Vg = lds + GL_VG;
    LDSP float* segs = (LDSP float*)(lds + GL_SEG);
    int task = obid(); CsPre R;
    if (task < 2048) cs_issue(p, task, tid, R);
    for (; task < 2048; task += G) {
        *(LDSP u32x4*)(LA + (tid >> 3) * 144 + (tid & 7) * 16) = R.la; *(LDSP u32x4*)(KK + (tid >> 3) * 144 + (tid & 7) * 16) = R.k;
#pragma unroll
        for (int i = 0; i < 2; ++i) { const int ch = tid + 512 * i; *(LDSP u32x4*)(Vg + (ch >> 4) * 272 + (ch & 15) * 16) = R.v[i]; }
        __syncthreads();
        if (task + G < 2048) cs_issue(p, task + G, tid, R);
        float la[8], kk[8];
#pragma unroll
        for (int jj = 0; jj < 8; ++jj) { const int j = seg * 8 + jj; la[jj] = bf2f(*(const LDSP unsigned short*)(LA + j * 144 + dk * 2)); kk[jj] = bf2f(*(const LDSP unsigned short*)(KK + j * 144 + dk * 2)); }
        float bc[8], total;
        gla_cumsum(la, segs, dk, seg, bc, total);
        { u32x4 o; float e[8];
#pragma unroll
          for (int jj = 0; jj < 8; ++jj) e[jj] = kk[jj] * __expf(total - bc[jj]);
          o[0] = pk2(e[0], e[1]); o[1] = pk2(e[2], e[3]); o[2] = pk2(e[4], e[5]); o[3] = pk2(e[6], e[7]);
          *(LDSP u32x4*)(KeT + dk * 144 + seg * 16) = o; }
        if (seg == 0) p.gdec[(size_t)task * 64 + dk] = __expf(total);
        __syncthreads();
        const int mt = w >> 1, nt0 = (w & 1) * 4, q4 = c >> 2, p4 = c & 3;
        f32x4 acc[4];
#pragma unroll
        for (int q = 0; q < 4; ++q) acc[q] = (f32x4){0.f, 0.f, 0.f, 0.f};
#pragma unroll
        for (int s = 0; s < 2; ++s) {
            const bf16x8 af = *(const LDSP bf16x8*)(KeT + (16 * mt + c) * 144 + (32 * s + 8 * g) * 2);
#pragma unroll
            for (int q = 0; q < 4; ++q) { const int cb = (16 * (nt0 + q) + 4 * p4) * 2;
                const s16x4 v0 = tr4(Vg, 32 * s + 8 * g + q4, 272, cb), v1 = tr4(Vg, 32 * s + 8 * g + 4 + q4, 272, cb);
                acc[q] = mfma16(cat8(v0, v1), af, acc[q]); }
        }
        bf16_t* gp = p.gst + (size_t)task * 8192 + (16 * mt + c) * 128 + 4 * g;
#pragma unroll
        for (int q = 0; q < 4; ++q) { u32x2 o; o[0] = pk2(acc[q][0], acc[q][1]); o[1] = pk2(acc[q][2], acc[q][3]); *(u32x2*)(gp + 16 * (nt0 + q)) = o; }
        __syncthreads();
    }
}

DI void gla_scan(const Params& p, bf16_t* dst) {
    const int tid = otid(), lane = tid & 63, seg = lane >> 4, gw = obid() * 8 + (tid >> 6), nw = gridDim.x * 8;
    for (int wi = gw; wi < 4096; wi += nw) {
        const int q = wi * 16 + (lane & 15), bh = q >> 11, kv4 = q & 2047, dk = kv4 >> 5;
        const size_t off = ((size_t)bh * 64 + seg * 16) * 8192 + kv4 * 4;
        const bf16_t* gp = p.gst + off; bf16_t* wp = dst + off; const float* dp = p.gdec + ((size_t)bh * 64 + seg * 16) * 64 + dk;
        u32x2 cs[16]; float dc[16];
#pragma unroll
        for (int i = 0; i < 16; ++i) { cs[i] = *(const u32x2*)(gp + (size_t)i * 8192); dc[i] = dp[i * 64]; }
        f32x4 loc[16]; float pp[16];
        f32x4 st = {0.f, 0.f, 0.f, 0.f}; float P = 1.f;
#pragma unroll
        for (int i = 0; i < 16; ++i) { loc[i] = st; pp[i] = P;
            const f32x4 cv = {__uint_as_float(cs[i][0] << 16), __uint_as_float(cs[i][0] & 0xFFFF0000u), __uint_as_float(cs[i][1] << 16), __uint_as_float(cs[i][1] & 0xFFFF0000u)};
            st = st * dc[i] + cv; P *= dc[i]; }
        f32x4 carry = {0.f, 0.f, 0.f, 0.f}, mine = carry;
#pragma unroll
        for (int sgi = 0; sgi < 3; ++sgi) { const int src = (lane & 15) + 16 * sgi;
            f32x4 S; S[0] = __shfl(st[0], src); S[1] = __shfl(st[1], src); S[2] = __shfl(st[2], src); S[3] = __shfl(st[3], src); const float Ps = __shfl(P, src);
            carry = carry * Ps + S; mine = (seg == sgi + 1) ? carry : mine; }
#pragma unroll
        for (int i = 0; i < 16; ++i) { const f32x4 o = loc[i] + mine * pp[i]; u32x2 ov; ov[0] = pk2(o[0], o[1]); ov[1] = pk2(o[2], o[3]); *(u32x2*)(wp + (size_t)i * 8192) = ov; }
    }
}

struct GoPre { u32x4 la, k, q, v[2], z[2], bf[2]; };
DI void go_issue(const Params& p, int task, int tid, GoPre& R) {
    const int bh = task >> 6, n = task & 63, b = bh >> 2, h = bh & 3;
    const bf16_t* rp = p.proj + ((size_t)b * SEQ + n * 64) * NP;
    { const bf16_t* q = rp + (size_t)(tid >> 3) * NP + h * 64 + (tid & 7) * 8; R.la = *(const u32x4*)(p.lab + ((size_t)b * SEQ + n * 64 + (tid >> 3)) * 256 + h * 64 + (tid & 7) * 8); R.k = *(const u32x4*)(q + C_KA); R.q = *(const u32x4*)(q + C_QA); }
#pragma unroll
    for (int i = 0; i < 2; ++i) { const int ch = tid + 512 * i; const bf16_t* q = rp + (size_t)(ch >> 4) * NP + h * 128 + (ch & 15) * 8; R.v[i] = *(const u32x4*)(q + C_VA); R.z[i] = *(const u32x4*)(q + C_ZA); }
    const bf16_t* gp = p.gst + (size_t)task * 8192;
#pragma unroll
    for (int i = 0; i < 2; ++i) R.bf[i] = *(const u32x4*)(gp + (tid + 512 * i) * 8);
}
DI void gla_out_phase(const Params& p, LDSP unsigned char* lds, int layer) {
    const int tid = otid(), w = tid >> 6, lane = tid & 63, c = lane & 15, g = lane >> 4, dk = tid & 63, seg = tid >> 6, G = gridDim.x;
    LDSP unsigned char* LA = lds + GL_LA; LDSP unsigned char* Ke = lds + GL_KK; LDSP unsigned char* Qe = lds + GL_QQ; LDSP unsigned char* Vg = lds + GL_VG;
    LDSP unsigned char* Bf = lds + GL_BF; LDSP unsigned char* Zt = lds + GL_ZT; LDSP unsigned char* Ost = lds + GL_OST;
    LDSP float* segs = (LDSP float*)(lds + GL_SEG); LDSP float* ssq = (LDSP float*)(lds + GL_SSQ);
    int task = obid(); GoPre R;
    if (task < 2048) go_issue(p, task, tid, R);
    for (; task < 2048; task += G) {
        const int bh = task >> 6, n = task & 63, b = bh >> 2, h = bh & 3;
        const size_t row0 = (size_t)b * SEQ + n * 64;
        { const int o = (tid >> 3) * 144 + (tid & 7) * 16; *(LDSP u32x4*)(LA + o) = R.la; *(LDSP u32x4*)(Ke + o) = R.k; *(LDSP u32x4*)(Qe + o) = R.q; }
#pragma unroll
        for (int i = 0; i < 2; ++i) { const int ch = tid + 512 * i, o = (ch >> 4) * 272 + (ch & 15) * 16; *(LDSP u32x4*)(Vg + o) = R.v[i]; *(LDSP u32x4*)(Zt + o) = R.z[i]; }
#pragma unroll
        for (int i = 0; i < 2; ++i) { const int e8 = tid + 512 * i; *(LDSP u32x4*)(Bf + (e8 >> 4) * 272 + (e8 & 15) * 16) = R.bf[i]; }
        __syncthreads();
        if (task + G < 2048) go_issue(p, task + G, tid, R);
        float la[8], kk[8], qq[8];
#pragma unroll
        for (int jj = 0; jj < 8; ++jj) { const int o = (seg * 8 + jj) * 144 + dk * 2; la[jj] = bf2f(*(const LDSP unsigned short*)(LA + o)); kk[jj] = bf2f(*(const LDSP unsigned short*)(Ke + o)); qq[jj] = bf2f(*(const LDSP unsigned short*)(Qe + o)); }
        float bc[8], total;
        gla_cumsum(la, segs, dk, seg, bc, total);
#pragma unroll
        for (int jj = 0; jj < 8; ++jj) { const int o = (seg * 8 + jj) * 144 + dk * 2; const float eb = __expf(bc[jj]), ebi = __expf(-bc[jj]);
            *(LDSP unsigned short*)(Qe + o) = f2bf(qq[jj] * eb); *(LDSP unsigned short*)(Ke + o) = f2bf(kk[jj] * ebi); }
        __syncthreads();
        const int it = w >> 1, nt0 = (w & 1) * 4, q4 = c >> 2, p4 = c & 3;
        bf16x8 qfr[2];
#pragma unroll
        for (int s = 0; s < 2; ++s) qfr[s] = *(const LDSP bf16x8*)(Qe + (16 * it + c) * 144 + (32 * s + 8 * g) * 2);
        f32x4 st[4];
#pragma unroll
        for (int jt = 0; jt < 4; ++jt) {
            f32x4 a4 = {0.f, 0.f, 0.f, 0.f};
#pragma unroll
            for (int s = 0; s < 2; ++s) { const bf16x8 kf = *(const LDSP bf16x8*)(Ke + (16 * jt + c) * 144 + (32 * s + 8 * g) * 2); a4 = mfma16(kf, qfr[s], a4); }
#pragma unroll
            for (int e = 0; e < 4; ++e) { const int j = 16 * jt + 4 * g + e, i = 16 * it + c; a4[e] = (j <= i) ? a4[e] : 0.f; }
            st[jt] = a4;
        }
        f32x4 oacc[4];
#pragma unroll
        for (int q = 0; q < 4; ++q) oacc[q] = (f32x4){0.f, 0.f, 0.f, 0.f};
#pragma unroll
        for (int s = 0; s < 2; ++s) {
            const bf16x8 sf = pack8(st[2 * s], st[2 * s + 1]);
#pragma unroll
            for (int q = 0; q < 4; ++q) { const int cb = (16 * (nt0 + q) + 4 * p4) * 2;
                const s16x4 b0 = tr4(Bf, 32 * s + 8 * g + q4, 272, cb), b1 = tr4(Bf, 32 * s + 8 * g + 4 + q4, 272, cb);
                oacc[q] = mfma16(cat8(b0, b1), qfr[s], oacc[q]);
                const s16x4 v0 = tr4(Vg, 32 * s + 4 * g + q4, 272, cb), v1 = tr4(Vg, 32 * s + 16 + 4 * g + q4, 272, cb);
                oacc[q] = mfma16(cat8(v0, v1), sf, oacc[q]); }
        }
        { float sq = 0.f;
#pragma unroll
          for (int q = 0; q < 4; ++q)
#pragma unroll
              for (int e = 0; e < 4; ++e) sq += oacc[q][e] * oacc[q][e];
          sq += __shfl_xor(sq, 16); sq += __shfl_xor(sq, 32);
          if (g == 0) ssq[(16 * it + c) * 2 + (w & 1)] = sq; }
        __syncthreads();
        { const int i = 16 * it + c; const float rinv = rsqrtf((ssq[i * 2] + ssq[i * 2 + 1]) * (1.0f / 128.0f) + EPS);
#pragma unroll
          for (int q = 0; q < 4; ++q) *(LDSP f32x4*)(Ost + i * 528 + (16 * (nt0 + q) + 4 * g) * 4) = oacc[q] * rinv; }
        __syncthreads();
        const float* gg = p.g_gla + layer * 512 + h * 128;
#pragma unroll
        for (int i2 = 0; i2 < 2; ++i2) { const int ch = tid + 512 * i2, row = ch >> 4, c16 = ch & 15;
            const f32x4 o0 = *(const LDSP f32x4*)(Ost + row * 528 + c16 * 32), o1 = *(const LDSP f32x4*)(Ost + row * 528 + c16 * 32 + 16);
            const u32x4 zv = *(const LDSP u32x4*)(Zt + row * 272 + c16 * 16);
            const f32x4 g0 = *(const f32x4*)(gg + c16 * 8), g1 = *(const f32x4*)(gg + c16 * 8 + 4);
            float y[8];
#pragma unroll
            for (int e = 0; e < 2; ++e) { y[2 * e] = o0[2 * e] * g0[2 * e] * silu(__uint_as_float(zv[e] << 16)); y[2 * e + 1] = o0[2 * e + 1] * g0[2 * e + 1] * silu(__uint_as_float(zv[e] & 0xFFFF0000u)); }
#pragma unroll
            for (int e = 0; e < 2; ++e) { y[4 + 2 * e] = o1[2 * e] * g1[2 * e] * silu(__uint_as_float(zv[2 + e] << 16)); y[5 + 2 * e] = o1[2 * e + 1] * g1[2 * e + 1] * silu(__uint_as_float(zv[2 + e] & 0xFFFF0000u)); }
            u32x4 ov; ov[0] = pk2(y[0], y[1]); ov[1] = pk2(y[2], y[3]); ov[2] = pk2(y[4], y[5]); ov[3] = pk2(y[6], y[7]);
            *(u32x4*)(p.hy + (row0 + row) * DM + h * 128 + c16 * 8) = ov; }
        __syncthreads();
    }
}

DI void attn_combine(const Params& p, int layer) {
    const int tid = otid(), lane = tid & 63, w = tid >> 6, head = lane >> 4, stride = gridDim.x * 8;
    for (int rowa = obid() * 8 + w; rowa < NTOK; rowa += 2 * stride) {
        int rows[2]; rows[0] = rowa; rows[1] = (rowa + stride < NTOK) ? rowa + stride : rowa;
        float ls[2][3]; u32x4 ov3[2][3], zv[2];
#pragma unroll
        for (int u = 0; u < 2; ++u) {
#pragma unroll
            for (int q = 0; q < 3; ++q) { ls[u][q] = p.attL[((size_t)q * NTOK + rows[u]) * 4 + head]; ov3[u][q] = *(const u32x4*)(p.attO + ((size_t)q * NTOK + rows[u]) * 512 + 8 * lane); }
            zv[u] = *(const u32x4*)(p.proj + (size_t)rows[u] * NP + C_ZB + 8 * lane);
        }
        const float* gg = p.g_dil + layer * 512 + 8 * lane;
        const f32x4 g0 = *(const f32x4*)gg, g1 = *(const f32x4*)(gg + 4);
#pragma unroll
        for (int u = 0; u < 2; ++u) {
            const float m = fmaxf(ls[u][0], fmaxf(ls[u][1], ls[u][2]));
            float wt[3], ws = 0.f;
#pragma unroll
            for (int q = 0; q < 3; ++q) { wt[q] = __expf(ls[u][q] - m); ws += wt[q]; }
            const float wi = 1.0f / ws;
            float o[8] = {0.f, 0.f, 0.f, 0.f, 0.f, 0.f, 0.f, 0.f};
#pragma unroll
            for (int q = 0; q < 3; ++q) { const float wq = wt[q] * wi;
#pragma unroll
                for (int e = 0; e < 4; ++e) { o[2 * e] += wq * __uint_as_float(ov3[u][q][e] << 16); o[2 * e + 1] += wq * __uint_as_float(ov3[u][q][e] & 0xFFFF0000u); } }
            float ss = 0.f;
#pragma unroll
            for (int e = 0; e < 8; ++e) ss += o[e] * o[e];
            ss += __shfl_xor(ss, 1); ss += __shfl_xor(ss, 2); ss += __shfl_xor(ss, 4); ss += __shfl_xor(ss, 8);
            const float rinv = rsqrtf(ss * (1.0f / 128.0f) + EPS);
            float y[8];
#pragma unroll
            for (int e = 0; e < 4; ++e) { const float z0 = __uint_as_float(zv[u][e] << 16), z1 = __uint_as_float(zv[u][e] & 0xFFFF0000u);
                const float ga = (e < 2) ? g0[2 * e] : g1[2 * e - 4], gb = (e < 2) ? g0[2 * e + 1] : g1[2 * e - 3];
                y[2 * e] = o[2 * e] * rinv * ga * silu(z0); y[2 * e + 1] = o[2 * e + 1] * rinv * gb * silu(z1); }
            u32x4 ov; ov[0] = pk2(y[0], y[1]); ov[1] = pk2(y[2], y[3]); ov[2] = pk2(y[4], y[5]); ov[3] = pk2(y[6], y[7]);
            *(u32x4*)(p.hy + (size_t)rows[u] * DM + 512 + 8 * lane) = ov;
        }
    }
}

__global__ void __launch_bounds__(512) fwd_megakernel(Params p) {
    extern __shared__ __attribute__((aligned(16))) unsigned char shm[];
    LDSP unsigned char* lds = (LDSP unsigned char*)shm;
    if (threadIdx.x == 0) *(LDSP u32x4*)(lds + LDS_BAR_OFF) = (u32x4){0u, 0u, 0u, 0u};
    __syncthreads();
    XcdBarrier xb = xcd_barrier_post(p.bar, (volatile LAS unsigned*)(lds + LDS_BAR_OFF));
    const int G = gridDim.x;
    phase0(p, lds);
    xcd_barrier(xb);
    for (int l = 0; l < 2; ++l) {
        if (l == 0) phase0c(p, lds);
        norm_pass(p, l);
        xcd_barrier(xb);
        { pg8::Gemm gm; gm.A = p.hy; gm.Bt = p.winT + (size_t)l * NP * 1024; gm.M = NTOK; gm.N = NP; gm.K = 1024;
          pg8::StaticOrder S; S.init(NTOK, NP, G, obid());
          EpiProj E; E.O = p.proj; E.rope = p.rope;
          pg8::gemm_phase<EpiProj, pg8::StaticOrder, GEMM_ALIGN, GEMM_SP2>(lds, gm, S, E); }
        lr_phase(p, lds, l);
        xcd_barrier(xb);
        attn2_phase(p, lds);
        gla_cs_phase(p, lds);
        xcd_barrier(xb);
        gla_scan(p, p.gst);
        xcd_barrier(xb);
        if ((obid() >> 3) % 3 == 0) { attn_combine(p, l); gla_out_phase(p, lds, l); } else { gla_out_phase(p, lds, l); attn_combine(p, l); }
        xcd_barrier(xb);
        { pg8::Gemm gm; gm.A = p.hy; gm.Bt = p.woutT + (size_t)l * 1024 * 1024; gm.M = NTOK; gm.N = DM; gm.K = 1024;
          pg8::StaticOrder S; S.init(NTOK, DM, G, obid());
          EpiOut E; E.C = l ? p.yout : (bf16_t*)p.out + 1024; E.ldc = l ? DM : 2048;
          pg8::gemm_phase<EpiOut, pg8::StaticOrder, GEMM_ALIGN, GEMM_SP2>(lds, gm, S, E); }
        xcd_barrier(xb);
    }
    norm_pass(p, 2);
}
}

extern "C" void kernel_launch(void* const* d_in, const int* in_sizes, int n_in, void* d_out, int out_size, void* d_ws, size_t ws_size, hipStream_t stream) {
    using namespace mk;
    static int grid_blocks = 0;
    if (!grid_blocks) {
        int dev = 0, cus = 0, per_cu = 0;
        hipGetDevice(&dev);
        hipDeviceGetAttribute(&cus, hipDeviceAttributeMultiprocessorCount, dev);
        hipFuncSetAttribute((const void*)fwd_megakernel, hipFuncAttributeMaxDynamicSharedMemorySize, LDS_BYTES);
        hipOccupancyMaxActiveBlocksPerMultiprocessor(&per_cu, (const void*)fwd_megakernel, 512, LDS_BYTES);
        if (per_cu < 1) { fprintf(stderr, "occupancy query returned %d\n", per_cu); per_cu = 1; }
        grid_blocks = cus;
    }
    Params p{};
    p.x = (const float*)d_in[0]; p.c = (const float*)d_in[1]; p.w_ada = (const float*)d_in[2]; p.b_ada = (const float*)d_in[3];
    p.g_pre = (const float*)d_in[4]; p.w_in = (const float*)d_in[5]; p.w_gu = (const float*)d_in[6]; p.b_gu = (const float*)d_in[7];
    p.g_gla = (const float*)d_in[8]; p.g_dil = (const float*)d_in[9]; p.w_out = (const float*)d_in[10]; p.g_post = (const float*)d_in[11];
    p.out = (float*)d_out;
    unsigned char* ws = (unsigned char*)d_ws; size_t off = 0;
    auto take = [&](size_t bytes) { unsigned char* r = ws + off; off += (bytes + 255) & ~(size_t)255; return r; };
    p.bar = (unsigned*)take(XCD_BAR_WORDS * 4);
    p.mod = (float*)take((size_t)2 * 8 * 3072 * 4);
    p.rope = (float2*)take((size_t)SEQ * 64 * 8);
    p.winT = (bf16_t*)take((size_t)2 * NP * 1024 * 2);
    p.woutT = (bf16_t*)take((size_t)2 * 1024 * 1024 * 2);
    p.hy = (bf16_t*)take((size_t)NTOK * DM * 2);
    p.proj = (bf16_t*)take((size_t)NTOK * NP * 2);
    p.yout = p.proj;
    p.attO = (bf16_t*)take((size_t)3 * NTOK * 512 * 2);
    p.attL = (float*)take((size_t)3 * NTOK * 4 * 4);
    p.gst = (bf16_t*)take((size_t)2048 * 8192 * 2);
    p.gdec = (float*)take((size_t)2048 * 64 * 4);
    p.wlrT = (bf16_t*)take((size_t)2 * 16 * 1024 * 2);
    p.lab = (bf16_t*)take((size_t)NTOK * 256 * 2);
    if (off > ws_size) fprintf(stderr, "workspace too small: need %zu have %zu\n", off, ws_size);
    hipMemsetAsync(p.bar, 0, XCD_BAR_WORDS * 4, stream);
    void* args[] = {&p};
    hipError_t e = hipLaunchCooperativeKernel((const void*)fwd_megakernel, dim3(grid_blocks), dim3(512), args, LDS_BYTES, stream);
    if (e != hipSuccess) fprintf(stderr, "cooperative launch failed: %s (grid %d)\n", hipGetErrorString(e), grid_blocks);
}
```
